# Optimizing an MI355X kernel written in HIP

```python
import math
import jax, jax.numpy as jnp
from jax import lax
import numpy as np

D_MODEL = 1024
BATCH = 16
SEQ = 256
DEPTH = 4
DEC_BATCH = 8
DEC_SEQ = 1024
PAST_LEN = 512

GRID_W = 64
N_EVEN = (DEPTH + 1) // 2
N_ODD = DEPTH // 2
EPS = 1e-6
ROPE_BASE = 10000.0
Q_BLOCK = 128
S5_WIDTH = D_MODEL // 2
S5_GROUP = 16
S5_GROUPS = S5_WIDTH // S5_GROUP
S5_STATE = 64
DIFF_HEAD_DIM = 64
DIFF_HEADS = (D_MODEL // 2) // (2 * DIFF_HEAD_DIM)
DIFF_WIDTH = DIFF_HEADS * 2 * DIFF_HEAD_DIM
EVEN_IN = S5_WIDTH + 3 * DIFF_WIDTH
EVEN_OUT = S5_WIDTH + DIFF_WIDTH
MLA_HEADS = 16
MLA_NOPE = 64
MLA_ROPE = 32
MLA_V = 64
MLA_Q_RANK = 256
MLA_KV_RANK = 128
ODD_IN = MLA_Q_RANK + MLA_KV_RANK + MLA_ROPE
D_FF = ((8 * D_MODEL // 3 + 255) // 256) * 256

kernel_name = 'hybrid_s5_diffattn_mla_flow_step'


def rmsnorm(x, g):
    xf = x.astype(jnp.float32)
    y = xf * lax.rsqrt(jnp.mean(xf * xf, axis=-1, keepdims=True) + EPS)
    return (y * g.astype(jnp.float32)).astype(x.dtype)


def axial_rope(n_tokens, rot_dim):
    rows = n_tokens // GRID_W
    row = jnp.repeat(jnp.arange(rows, dtype=jnp.float32), GRID_W)
    col = jnp.tile(jnp.arange(GRID_W, dtype=jnp.float32), rows)
    n_freq = rot_dim // 4
    inv = ROPE_BASE ** (-jnp.arange(n_freq, dtype=jnp.float32) / n_freq)
    ang = jnp.concatenate([row[:, None] * inv, col[:, None] * inv], axis=-1)
    return jnp.cos(ang), jnp.sin(ang)


def apply_rope(x, cos, sin):
    half = x.shape[-1] // 2
    shape = (x.shape[1],) + (1,) * (x.ndim - 3) + (half,)
    c = cos.reshape(shape).astype(x.dtype)
    s = sin.reshape(shape).astype(x.dtype)
    x1, x2 = x[..., :half], x[..., half:]
    return jnp.concatenate([x1 * c - x2 * s, x2 * c + x1 * s], axis=-1)


def map_query_blocks(fn, *qs):
    b, n = qs[0].shape[:2]
    nb = n // Q_BLOCK
    blocked = tuple(jnp.moveaxis(q.reshape((b, nb, Q_BLOCK) + q.shape[2:]), 1, 0) for q in qs)
    out = lax.map(lambda qb: fn(*qb), blocked)
    return jnp.moveaxis(out, 0, 1).reshape((b, n) + out.shape[3:])


def complex_affine_combine(e1, e2):
    a1r, a1i, b1r, b1i = e1
    a2r, a2i, b2r, b2i = e2
    ar = a2r * a1r - a2i * a1i
    ai = a2r * a1i + a2i * a1r
    br = a2r * b1r - a2i * b1i + b2r
    bi = a2r * b1i + a2i * b1r + b2i
    return ar, ai, br, bi


def s5_direction(u, h0_re, h0_im, lam_re, lam_im, log_dt, b_re, b_im, c_re, c_im, reverse):
    f32 = jnp.float32
    lr, li = lam_re.astype(f32), lam_im.astype(f32)
    dt = jnp.exp(log_dt.astype(f32))[:, None]
    mag = jnp.exp(lr * dt)
    a_re, a_im = mag * jnp.cos(li * dt), mag * jnp.sin(li * dt)
    den = lr * lr + li * li
    f_re = ((a_re - 1.0) * lr + a_im * li) / den
    f_im = (a_im * lr - (a_re - 1.0) * li) / den
    br, bi = b_re.astype(f32), b_im.astype(f32)
    bb_re = f_re[..., None] * br - f_im[..., None] * bi
    bb_im = f_re[..., None] * bi + f_im[..., None] * br
    bu_re = jnp.einsum('bngh,gph->bngp', u, bb_re)
    bu_im = jnp.einsum('bngh,gph->bngp', u, bb_im)
    edge = -1 if reverse else 0
    h0r, h0i = h0_re.astype(f32), h0_im.astype(f32)
    bu_re = bu_re.at[:, edge].add(a_re * h0r - a_im * h0i)
    bu_im = bu_im.at[:, edge].add(a_re * h0i + a_im * h0r)
    ar = jnp.broadcast_to(a_re, bu_re.shape)
    ai = jnp.broadcast_to(a_im, bu_re.shape)
    _, _, hr, hi = lax.associative_scan(complex_affine_combine, (ar, ai, bu_re, bu_im), reverse=reverse, axis=1)
    y = jnp.einsum('bngp,ghp->bngh', hr, c_re.astype(f32)) - jnp.einsum('bngp,ghp->bngh', hi, c_im.astype(f32))
    fin = 0 if reverse else -1
    return y, hr[:, fin], hi[:, fin]


def s5_mixer(u, h0_re, h0_im, lam_re, lam_im, log_dt, b_re, b_im, c_re, c_im, d, glu_w, glu_b):
    b, n, _ = u.shape
    uf = u.astype(jnp.float32).reshape(b, n, S5_GROUPS, S5_GROUP)
    y_f, fr_f, fi_f = s5_direction(uf, h0_re[:, 0], h0_im[:, 0], lam_re[0], lam_im[0], log_dt[0],
                                   b_re[0], b_im[0], c_re[0], c_im[0], False)
    y_b, fr_b, fi_b = s5_direction(uf, h0_re[:, 1], h0_im[:, 1], lam_re[1], lam_im[1], log_dt[1],
                                   b_re[1], b_im[1], c_re[1], c_im[1], True)
    y = y_f + y_b + d.astype(jnp.float32).reshape(S5_GROUPS, S5_GROUP) * uf
    g = jax.nn.gelu(y.reshape(b, n, S5_WIDTH))
    out = g * jax.nn.sigmoid(g @ glu_w.astype(jnp.float32) + glu_b.astype(jnp.float32))
    fin_re = jnp.stack([fr_f, fr_b], axis=1)
    fin_im = jnp.stack([fi_f, fi_b], axis=1)
    return out.astype(u.dtype), fin_re, fin_im


def diff_attention(q, k, v, lam, lam_init, subln_g):
    b, n = q.shape[:2]
    scale = DIFF_HEAD_DIM ** -0.5
    kf, vf = k.astype(jnp.float32), v.astype(jnp.float32)

    def attend(qb):
        s = jnp.einsum('bqhcd,bkhcd->bhcqk', qb.astype(jnp.float32), kf) * scale
        p = jax.nn.softmax(s, axis=-1)
        w = p[:, :, 0] - lam * p[:, :, 1]
        return jnp.einsum('bhqk,bkhe->bqhe', w, vf)

    o = map_query_blocks(attend, q)
    o = rmsnorm(o, subln_g) * (1.0 - lam_init)
    return o.reshape(b, n, DIFF_WIDTH).astype(q.dtype)


def mla_attention(qn, qr, kn, kr, v):
    b, n = qn.shape[:2]
    scale = (MLA_NOPE + MLA_ROPE) ** -0.5
    knf, krf, vf = kn.astype(jnp.float32), kr.astype(jnp.float32), v.astype(jnp.float32)

    def attend(qnb, qrb):
        s = (jnp.einsum('bqhd,bkhd->bhqk', qnb.astype(jnp.float32), knf)
             + jnp.einsum('bqhr,bkr->bhqk', qrb.astype(jnp.float32), krf)) * scale
        p = jax.nn.softmax(s, axis=-1)
        return jnp.einsum('bhqk,bkhd->bqhd', p, vf)

    o = map_query_blocks(attend, qn, qr)
    return o.reshape(b, n, MLA_HEADS * MLA_V).astype(qn.dtype)


def block(x, cond, w_mod, b_mod, g_pre_mix, g_post_mix, g_pre_ffn, g_post_ffn, w_gate, w_up, w_down, mixer):
    mod = (jax.nn.silu(cond) @ w_mod + b_mod)[:, None, :]
    sh1, sc1, g1, sh2, sc2, g2 = jnp.split(mod, 6, axis=-1)
    h = rmsnorm(x, g_pre_mix) * (1.0 + sc1) + sh1
    y, aux = mixer(h)
    x = x + g1 * rmsnorm(y, g_post_mix)
    h = rmsnorm(x, g_pre_ffn) * (1.0 + sc2) + sh2
    y = (jax.nn.silu(h @ w_gate) * (h @ w_up)) @ w_down
    x = x + g2 * rmsnorm(y, g_post_ffn)
    return x, aux


def setup_inputs(seed: int = 0) -> dict:
    key = jax.random.key(seed)
    ks = iter(jax.random.split(key, 64))
    f32 = jnp.float32

    def nrm(shape, scale=1.0):
        return jax.random.normal(next(ks), shape, f32) * scale

    def gain(shape):
        return 1.0 + nrm(shape, 0.01)

    lam_re = -0.5 + nrm((N_EVEN, 2, S5_GROUPS, S5_STATE), 0.01)
    lam_im = math.pi * jnp.arange(S5_STATE, dtype=f32) + nrm((N_EVEN, 2, S5_GROUPS, S5_STATE), 0.01)
    log_dt = jax.random.uniform(next(ks), (N_EVEN, 2, S5_GROUPS), f32, math.log(1e-3), math.log(1e-1))
    return {
        'x_prompt': nrm((BATCH, SEQ, D_MODEL)),
        'x_sample': nrm((DEC_BATCH, DEC_SEQ, D_MODEL)),
        'state_s5_re': nrm((DEC_BATCH, N_EVEN, 2, S5_GROUPS, S5_STATE), 0.5),
        'state_s5_im': nrm((DEC_BATCH, N_EVEN, 2, S5_GROUPS, S5_STATE), 0.5),
        'cache_diff_k': nrm((DEC_BATCH, N_EVEN, PAST_LEN, DIFF_HEADS, 2, DIFF_HEAD_DIM)),
        'cache_diff_v': nrm((DEC_BATCH, N_EVEN, PAST_LEN, DIFF_HEADS, 2 * DIFF_HEAD_DIM)),
        'cache_mla_ckv': nrm((DEC_BATCH, N_ODD, PAST_LEN, MLA_KV_RANK)),
        'cache_mla_krope': nrm((DEC_BATCH, N_ODD, PAST_LEN, MLA_ROPE)),
        'c': nrm((DEC_BATCH, D_MODEL)),
        'c_ctx': nrm((D_MODEL,)),
        'w_mod': nrm((DEPTH, D_MODEL, 6 * D_MODEL), D_MODEL ** -0.5),
        'b_mod': nrm((DEPTH, 6 * D_MODEL), 0.01),
        'g_pre_mix': gain((DEPTH, D_MODEL)),
        'g_post_mix': gain((DEPTH, D_MODEL)),
        'g_pre_ffn': gain((DEPTH, D_MODEL)),
        'g_post_ffn': gain((DEPTH, D_MODEL)),
        'w_ffn_gate': nrm((DEPTH, D_MODEL, D_FF), D_MODEL ** -0.5),
        'w_ffn_up': nrm((DEPTH, D_MODEL, D_FF), D_MODEL ** -0.5),
        'w_ffn_down': nrm((DEPTH, D_FF, D_MODEL), D_FF ** -0.5),
        'w_in_even': nrm((N_EVEN, D_MODEL, EVEN_IN), D_MODEL ** -0.5),
        'w_out_even': nrm((N_EVEN, EVEN_OUT, D_MODEL), EVEN_OUT ** -0.5),
        's5_lam_re': lam_re,
        's5_lam_im': lam_im,
        's5_log_dt': log_dt,
        's5_b_re': nrm((N_EVEN, 2, S5_GROUPS, S5_STATE, S5_GROUP), (2 * S5_GROUP) ** -0.5),
        's5_b_im': nrm((N_EVEN, 2, S5_GROUPS, S5_STATE, S5_GROUP), (2 * S5_GROUP) ** -0.5),
        's5_c_re': nrm((N_EVEN, 2, S5_GROUPS, S5_GROUP, S5_STATE), (2 * S5_STATE) ** -0.5),
        's5_c_im': nrm((N_EVEN, 2, S5_GROUPS, S5_GROUP, S5_STATE), (2 * S5_STATE) ** -0.5),
        's5_d': nrm((N_EVEN, S5_WIDTH)),
        's5_glu_w': nrm((N_EVEN, S5_WIDTH, S5_WIDTH), S5_WIDTH ** -0.5),
        's5_glu_b': nrm((N_EVEN, S5_WIDTH), 0.01),
        'diff_lam_q1': nrm((N_EVEN, DIFF_HEAD_DIM), 0.1),
        'diff_lam_k1': nrm((N_EVEN, DIFF_HEAD_DIM), 0.1),
        'diff_lam_q2': nrm((N_EVEN, DIFF_HEAD_DIM), 0.1),
        'diff_lam_k2': nrm((N_EVEN, DIFF_HEAD_DIM), 0.1),
        'diff_subln_g': gain((N_EVEN, 2 * DIFF_HEAD_DIM)),
        'w_in_odd': nrm((N_ODD, D_MODEL, ODD_IN), D_MODEL ** -0.5),
        'mla_q_norm_g': gain((N_ODD, MLA_Q_RANK)),
        'mla_w_q_up': nrm((N_ODD, MLA_Q_RANK, MLA_HEADS * (MLA_NOPE + MLA_ROPE)), MLA_Q_RANK ** -0.5),
        'mla_kv_norm_g': gain((N_ODD, MLA_KV_RANK)),
        'mla_w_kv_up': nrm((N_ODD, MLA_KV_RANK, MLA_HEADS * (MLA_NOPE + MLA_V)), MLA_KV_RANK ** -0.5),
        'w_out_odd': nrm((N_ODD, MLA_HEADS * MLA_V, D_MODEL), (MLA_HEADS * MLA_V) ** -0.5),
    }


def reference(x_prompt, x_sample, state_s5_re, state_s5_im, cache_diff_k, cache_diff_v, cache_mla_ckv,
              cache_mla_krope, c, c_ctx, w_mod, b_mod, g_pre_mix, g_post_mix, g_pre_ffn, g_post_ffn,
              w_ffn_gate, w_ffn_up, w_ffn_down, w_in_even, w_out_even, s5_lam_re, s5_lam_im, s5_log_dt,
              s5_b_re, s5_b_im, s5_c_re, s5_c_im, s5_d, s5_glu_w, s5_glu_b, diff_lam_q1, diff_lam_k1,
              diff_lam_q2, diff_lam_k2, diff_subln_g, w_in_odd, mla_q_norm_g, mla_w_q_up, mla_kv_norm_g,
              mla_w_kv_up, w_out_odd):
    n_lat = x_sample.shape[1]
    cos_d, sin_d = axial_rope(n_lat, DIFF_HEAD_DIM)
    cos_m, sin_m = axial_rope(n_lat, MLA_ROPE)
    cond_ctx = c_ctx[None, :]

    def even_mixer(h, e, lam_init, ctx):
        b, n, _ = h.shape
        proj = h @ w_in_even[e]
        u = proj[..., :S5_WIDTH]
        q = proj[..., S5_WIDTH:S5_WIDTH + DIFF_WIDTH].reshape(b, n, DIFF_HEADS, 2, DIFF_HEAD_DIM)
        k = proj[..., S5_WIDTH + DIFF_WIDTH:S5_WIDTH + 2 * DIFF_WIDTH].reshape(b, n, DIFF_HEADS, 2, DIFF_HEAD_DIM)
        v = proj[..., S5_WIDTH + 2 * DIFF_WIDTH:].reshape(b, n, DIFF_HEADS, 2 * DIFF_HEAD_DIM)
        if ctx is None:
            h0_re = jnp.zeros((b, 2, S5_GROUPS, S5_STATE), jnp.float32)
            h0_im = h0_re
            k_all, v_all = k, v
        else:
            h0_re, h0_im, ck, cv = ctx
            q = apply_rope(q, cos_d, sin_d)
            k = apply_rope(k, cos_d, sin_d)
            k_all = jnp.concatenate([ck.astype(k.dtype), k], axis=1)
            v_all = jnp.concatenate([cv.astype(v.dtype), v], axis=1)
        s5_out, fin_re, fin_im = s5_mixer(u, h0_re, h0_im, s5_lam_re[e], s5_lam_im[e], s5_log_dt[e],
                                          s5_b_re[e], s5_b_im[e], s5_c_re[e], s5_c_im[e], s5_d[e],
                                          s5_glu_w[e], s5_glu_b[e])
        lam = (jnp.exp(jnp.sum(diff_lam_q1[e].astype(jnp.float32) * diff_lam_k1[e].astype(jnp.float32)))
               - jnp.exp(jnp.sum(diff_lam_q2[e].astype(jnp.float32) * diff_lam_k2[e].astype(jnp.float32)))
               + lam_init)
        diff_out = diff_attention(q, k_all, v_all, lam, lam_init, diff_subln_g[e])
        y = jnp.concatenate([s5_out, diff_out], axis=-1) @ w_out_even[e]
        return y, (fin_re, fin_im, k, v)

    def odd_mixer(h, o, ctx):
        b, n, _ = h.shape
        proj = h @ w_in_odd[o]
        cq = rmsnorm(proj[..., :MLA_Q_RANK], mla_q_norm_g[o])
        ckv = rmsnorm(proj[..., MLA_Q_RANK:MLA_Q_RANK + MLA_KV_RANK], mla_kv_norm_g[o])
        kr = proj[..., MLA_Q_RANK + MLA_KV_RANK:]
        q = (cq @ mla_w_q_up[o]).reshape(b, n, MLA_HEADS, MLA_NOPE + MLA_ROPE)
        qn, qr = q[..., :MLA_NOPE], q[..., MLA_NOPE:]
        if ctx is None:
            ckv_all, kr_all = ckv, kr
        else:
            c_ckv, c_kr = ctx
            qr = apply_rope(qr, cos_m, sin_m)
            kr_rot = apply_rope(kr, cos_m, sin_m)
            ckv_all = jnp.concatenate([c_ckv.astype(ckv.dtype), ckv], axis=1)
            kr_all = jnp.concatenate([c_kr.astype(kr.dtype), kr_rot], axis=1)
        s_len = ckv_all.shape[1]
        kv = (ckv_all @ mla_w_kv_up[o]).reshape(b, s_len, MLA_HEADS, MLA_NOPE + MLA_V)
        kn, v = kv[..., :MLA_NOPE], kv[..., MLA_NOPE:]
        y = mla_attention(qn, qr, kn, kr_all, v) @ w_out_odd[o]
        return y, (ckv, kr)

    xp, xs = x_prompt, x_sample
    s5_re_list, s5_im_list, dk_list, dv_list, ckv_list, kr_list = [], [], [], [], [], []
    for l in range(DEPTH):
        common = (w_mod[l], b_mod[l], g_pre_mix[l], g_post_mix[l], g_pre_ffn[l], g_post_ffn[l],
                  w_ffn_gate[l], w_ffn_up[l], w_ffn_down[l])
        if l % 2 == 0:
            e = l // 2
            lam_init = 0.8 - 0.6 * math.exp(-0.3 * l)
            xp, (fr, fi, ck, cv) = block(xp, cond_ctx, *common,
                                         mixer=lambda h: even_mixer(h, e, lam_init, None))
            ctx = (state_s5_re[:, e], state_s5_im[:, e], cache_diff_k[:, e], cache_diff_v[:, e])
            xs, _ = block(xs, c, *common, mixer=lambda h: even_mixer(h, e, lam_init, ctx))
            s5_re_list.append(fr)
            s5_im_list.append(fi)
            dk_list.append(ck)
            dv_list.append(cv)
        else:
            o = l // 2
            xp, (ckv, kr) = block(xp, cond_ctx, *common, mixer=lambda h: odd_mixer(h, o, None))
            ctx = (cache_mla_ckv[:, o], cache_mla_krope[:, o])
            xs, _ = block(xs, c, *common, mixer=lambda h: odd_mixer(h, o, ctx))
            ckv_list.append(ckv)
            kr_list.append(kr)

    new_s5_re = jnp.stack(s5_re_list, axis=1).astype(state_s5_re.dtype)
    new_s5_im = jnp.stack(s5_im_list, axis=1).astype(state_s5_im.dtype)
    new_dk = jnp.stack(dk_list, axis=1)
    new_dv = jnp.stack(dv_list, axis=1)
    new_ckv = jnp.stack(ckv_list, axis=1)
    new_kr = jnp.stack(kr_list, axis=1)
    return (xp, xs, new_s5_re, new_s5_im, new_dk, new_dv, new_ckv, new_kr)
```

```cpp
#include <hip/hip_runtime.h>
#include <hip/hip_cooperative_groups.h>
#include <stdint.h>
#include <stdio.h>
namespace cg = cooperative_groups;

typedef unsigned short bf16_t;
typedef __attribute__((ext_vector_type(8))) __bf16 bf16x8;
typedef __attribute__((ext_vector_type(16))) float f32x16;
typedef __attribute__((ext_vector_type(4))) unsigned int u32x4;
typedef __attribute__((ext_vector_type(2))) unsigned int u32x2;
typedef __attribute__((ext_vector_type(4))) float f32x4nt;
#define DEV __device__ __forceinline__

constexpr int NTOK = 12288;
constexpr int NCTX = 4096;
constexpr float EPS = 1e-6f;

constexpr size_t O_S5RE = 12582912, O_S5IM = 12713984, O_DK = 12845056, O_DV = 17039360,
                 O_CKV = 21233664, O_KR = 22282240;

constexpr size_t al(size_t x) { return (x + 255) & ~size_t(255); }
constexpr size_t WS_MOD   = 0;
constexpr size_t WS_ROPED = WS_MOD + al(4 * 9 * 6144 * 4);
constexpr size_t WS_ROPEM = WS_ROPED + al(2 * 1024 * 32 * 4);
constexpr size_t WS_LAM   = WS_ROPEM + al(2 * 1024 * 16 * 4);
constexpr size_t WS_AT    = WS_LAM + 256;
constexpr size_t WS_GT    = WS_AT + al(2 * 2 * 32 * 64 * 2 * 4);
constexpr size_t WS_TET   = WS_GT + (size_t)2 * 32 * 256 * 256 * 2;
constexpr size_t WS_WGU   = WS_TET + (size_t)2 * 32 * 256 * 512 * 2;
constexpr size_t WS_WD    = WS_WGU + (size_t)4 * 5632 * 1024 * 2;
constexpr size_t WS_WINE  = WS_WD + (size_t)4 * 1024 * 2816 * 2;
constexpr size_t WS_WOUTE = WS_WINE + (size_t)2 * 2048 * 1024 * 2;
constexpr size_t WS_GLU   = WS_WOUTE + (size_t)2 * 1024 * 1024 * 2;
constexpr size_t WS_WINO  = WS_GLU + (size_t)2 * 512 * 512 * 2;
constexpr size_t WS_WQ    = WS_WINO + (size_t)2 * 512 * 1024 * 2;
constexpr size_t WS_WKV   = WS_WQ + (size_t)2 * 1536 * 256 * 2;
constexpr size_t WS_WOUTO = WS_WKV + (size_t)2 * 2048 * 128 * 2;
constexpr size_t WS_H     = WS_WOUTO + (size_t)2 * 1024 * 1024 * 2;
constexpr size_t WS_YCAT  = WS_H + (size_t)NTOK * 1024 * 2;
constexpr size_t WS_Y     = WS_YCAT + (size_t)NTOK * 1024 * 2;
constexpr size_t WS_MIX   = WS_Y + (size_t)NTOK * 1024 * 2;
constexpr size_t WS_ACT   = WS_MIX;
constexpr size_t WS_UG    = WS_MIX;
constexpr size_t WS_QD    = WS_UG + (size_t)NTOK * 512 * 2;
constexpr size_t WS_KD    = WS_QD + (size_t)NTOK * 512 * 2;
constexpr size_t WS_VTDC  = WS_KD + (size_t)16384 * 512 * 2;
constexpr size_t WS_VTDL  = WS_VTDC + (size_t)16 * 4 * 128 * 256 * 2;
constexpr size_t WS_S     = WS_VTDL + (size_t)8 * 4 * 128 * 1536 * 2;
constexpr size_t WS_HIN   = WS_S + (size_t)32 * 768 * 256 * 4;
constexpr size_t WS_G     = WS_HIN + (size_t)32 * 768 * 256 * 2;
constexpr size_t WS_PROJO = WS_MIX;
constexpr size_t WS_CQ    = WS_PROJO + (size_t)NTOK * 416 * 4;
constexpr size_t WS_QM    = WS_CQ + (size_t)NTOK * 256 * 2;
constexpr size_t WS_KN    = WS_QM + (size_t)NTOK * 1536 * 2;
constexpr size_t WS_VTMC  = WS_KN + (size_t)16384 * 1024 * 2;
constexpr size_t WS_VTML  = WS_VTMC + (size_t)16 * 16 * 64 * 256 * 2;
constexpr size_t WS_CKVA  = WS_VTML + (size_t)8 * 16 * 64 * 1536 * 2;
constexpr size_t WS_KRA   = WS_CKVA + (size_t)16384 * 128 * 2;
constexpr size_t WS_END   = WS_KRA + (size_t)16384 * 32 * 2;

constexpr size_t WS_BAR   = al(WS_END);
constexpr size_t WS_Y2    = al(WS_BAR + 3456 * 4);
constexpr size_t WS_XB    = al(WS_Y2 + 256);
constexpr int SMEM_VB = 73728;
constexpr int SMEM_BYTES = 2 * SMEM_VB + 16;

struct Params {
  const float* in[42];
  float* out;
  char* ws;
};

enum { I_XP = 0, I_XS, I_S5RE, I_S5IM, I_CDK, I_CDV, I_CCKV, I_CKR, I_C, I_CCTX, I_WMOD, I_BMOD,
       I_GPREMIX, I_GPOSTMIX, I_GPREFFN, I_GPOSTFFN, I_WGATE, I_WUP, I_WDOWN, I_WINE, I_WOUTE,
       I_LAMRE, I_LAMIM, I_LOGDT, I_BRE, I_BIM, I_CRE, I_CIM, I_S5D, I_GLUW, I_GLUB,
       I_LQ1, I_LK1, I_LQ2, I_LK2, I_SUBLN, I_WINO, I_QNORM, I_WQUP, I_KVNORM, I_WKVUP, I_WOUTO };

typedef __bf16 hbf16x2 __attribute__((ext_vector_type(2)));
typedef float f32x2v __attribute__((ext_vector_type(2)));
DEV uint32_t pack2(float a, float b) {
  const f32x2v v = {a, b};
  return __builtin_bit_cast(uint32_t, __builtin_convertvector(v, hbf16x2));
}
DEV bf16_t f2bf(float f) { return (bf16_t)(pack2(f, f) & 0xffffu); }
DEV u32x2 mk2(unsigned a, unsigned b) { u32x2 v; v.x = a; v.y = b; return v; }
DEV u32x4 mk4(unsigned a, unsigned b, unsigned c, unsigned d) { u32x4 v; v.x = a; v.y = b; v.z = c; v.w = d; return v; }
DEV float bf2f(bf16_t b) { return __uint_as_float((uint32_t)b << 16); }
DEV int opaque_tid() { int t = threadIdx.x & 255; asm volatile("" : "+v"(t)); return t; }
#define VBID ((int)(blockIdx.x * 2 + __builtin_amdgcn_readfirstlane(threadIdx.x >> 8)))
#define VNB ((int)(gridDim.x * 2))
DEV float wave_sum(float v) {
#pragma unroll
  for (int o = 32; o >= 1; o >>= 1) v += __shfl_xor(v, o);
  return v;
}
DEV float fast_exp2(float x) { return __builtin_amdgcn_exp2f(x); }
DEV float sigmoidf(float x) { return __builtin_amdgcn_rcpf(1.f + fast_exp2(-1.4426950408889634f * x)); }
DEV float siluf(float x) { return x * sigmoidf(x); }
DEV float gelu_tanh(float x) {
  float u = 0.7978845608028654f * (x + 0.044715f * x * x * x);
  float t = 1.f - 2.f * __builtin_amdgcn_rcpf(fast_exp2(2.8853900817779268f * u) + 1.f);
  return 0.5f * x * (1.f + t);
}
DEV f32x16 mfma(bf16x8 a, bf16x8 b, f32x16 c) { return __builtin_amdgcn_mfma_f32_32x32x16_bf16(a, b, c, 0, 0, 0); }

template <class AF>
DEV void gemm_mainloop(AF aptr, const bf16_t* __restrict__ Bt, int ldb, int K, bf16_t* smem, f32x16 (&acc)[2][2]) {
  const int tid = opaque_tid(), lane = tid & 63, w = tid >> 6;
  const int r = lane & 31, h = lane >> 5, wm = w >> 1, wn = w & 1;
  const int kc = tid & 7, lr = tid >> 3;
  u32x4 ra0[4], rb0[4], ra1[4], rb1[4];
  const int wofs = lr * 72 + kc * 8;
  const int aofs = (wm * 64 + r) * 72 + h * 8;
  const int bofs = 9216 + (wn * 64 + r) * 72 + h * 8;
#define GLOAD(RA, RB, K0)                                                              \
  _Pragma("unroll") for (int i = 0; i < 4; ++i) {                                      \
    RA[i] = *(const u32x4*)aptr(lr + 32 * i, (K0) + kc * 8);                           \
    RB[i] = *(const u32x4*)(Bt + (size_t)(lr + 32 * i) * ldb + (K0) + kc * 8);         \
  }
#define WA(RA, BUF, I) *(u32x4*)(smem + (BUF) * 18432 + wofs + (I) * 2304) = RA[I];
#define WB(RB, BUF, I) *(u32x4*)(smem + (BUF) * 18432 + 9216 + wofs + (I) * 2304) = RB[I];
#define FRAGS(BUF, KS, A0, A1, B0, B1)                                                 \
  A0 = *(const bf16x8*)(smem + (BUF) * 18432 + aofs + (KS) * 16);                      \
  A1 = *(const bf16x8*)(smem + (BUF) * 18432 + aofs + 32 * 72 + (KS) * 16);            \
  B0 = *(const bf16x8*)(smem + (BUF) * 18432 + bofs + (KS) * 16);                      \
  B1 = *(const bf16x8*)(smem + (BUF) * 18432 + bofs + 32 * 72 + (KS) * 16);
#define MMA4(A0, A1, B0, B1)                                                           \
  acc[0][0] = mfma(A0, B0, acc[0][0]);                                                 \
  acc[0][1] = mfma(A0, B1, acc[0][1]);                                                 \
  acc[1][0] = mfma(A1, B0, acc[1][0]);                                                 \
  acc[1][1] = mfma(A1, B1, acc[1][1]);
#define STEP(CB, WBUF, RA, RB, EN)                                                     \
  {                                                                                    \
    bf16x8 a0, a1, b0, b1, c0, c1, d0, d1;                                             \
    FRAGS(CB, 0, a0, a1, b0, b1)                                                       \
    FRAGS(CB, 1, c0, c1, d0, d1)                                                       \
    MMA4(a0, a1, b0, b1)                                                               \
    __builtin_amdgcn_sched_barrier(0);                                                 \
    FRAGS(CB, 2, a0, a1, b0, b1)                                                       \
    if (EN) { WA(RA, WBUF, 0) WB(RB, WBUF, 0) }                                        \
    MMA4(c0, c1, d0, d1)                                                               \
    __builtin_amdgcn_sched_barrier(0);                                                 \
    FRAGS(CB, 3, c0, c1, d0, d1)                                                       \
    if (EN) { WA(RA, WBUF, 1) WB(RB, WBUF, 1) WA(RA, WBUF, 2) }                        \
    MMA4(a0, a1, b0, b1)                                                               \
    __builtin_amdgcn_sched_barrier(0);                                                 \
    if (EN) { WB(RB, WBUF, 2) WA(RA, WBUF, 3) WB(RB, WBUF, 3) }                        \
    MMA4(c0, c1, d0, d1)                                                               \
    __builtin_amdgcn_sched_barrier(0);                                                 \
  }
  GLOAD(ra0, rb0, 0)
  GLOAD(ra1, rb1, 64)
#pragma unroll
  for (int a = 0; a < 2; ++a)
#pragma unroll
    for (int b = 0; b < 2; ++b)
#pragma unroll
      for (int i = 0; i < 16; ++i) acc[a][b][i] = 0.f;
  const int nk = K >> 6;
#pragma unroll
  for (int i = 0; i < 4; ++i) { WA(ra0, 0, i) WB(rb0, 0, i) }
  __syncthreads();
  for (int kt = 0; kt < nk; kt += 2) {
    if (kt + 2 < nk) { GLOAD(ra0, rb0, (kt + 2) << 6) }
    STEP(0, 1, ra1, rb1, true)
    __syncthreads();
    if (kt + 3 < nk) { GLOAD(ra1, rb1, (kt + 3) << 6) }
    STEP(1, 0, ra0, rb0, (kt + 2 < nk))
    __syncthreads();
  }
#undef GLOAD
#undef WA
#undef WB
#undef FRAGS
#undef MMA4
#undef STEP
}

#define LANE_VARS                                                   \
  const int tid = opaque_tid(), lane = tid & 63, w = tid >> 6;       \
  const int r = lane & 31, h = lane >> 5, wm = w >> 1, wn = w & 1;  \
  (void)tid; (void)lane; (void)w; (void)r; (void)h; (void)wm; (void)wn;
#define ACC_ROW(tm, i) (wm * 64 + (tm) * 32 + ((i) & 3) + 8 * ((i) >> 2) + 4 * h)

DEV void transpose_tile(const float* __restrict__ src, int lds_, int N, bf16_t* __restrict__ dst, int ldd,
                        int kt, int nt, int mode, float* sm) {
  const int tid = opaque_tid();
  __syncthreads();
  {
    float4 v[8];
#pragma unroll
    for (int i = 0; i < 8; ++i) {
      const int id = tid + i * 256;
      const int kk = id >> 5, n = nt * 128 + (id & 31) * 4;
      v[i] = make_float4(0.f, 0.f, 0.f, 0.f);
      if (n < N) v[i] = *(const float4*)(src + (size_t)(kt * 64 + kk) * lds_ + n);
    }
#pragma unroll
    for (int i = 0; i < 8; ++i) {
      const int id = tid + i * 256;
      float* d = sm + (id >> 5) * 129 + (id & 31) * 4;
      d[0] = v[i].x; d[1] = v[i].y; d[2] = v[i].z; d[3] = v[i].w;
    }
  }
  __syncthreads();
#pragma unroll
  for (int i = 0; i < 4; ++i) {
    const int id = tid + i * 256;
    const int nn = id >> 3, c = id & 7;
    const int n = nt * 128 + nn;
    int np = n;
    if (mode == 1) np = (n >> 7) * 256 + (n & 127);
    else if (mode == 2) np = (n >> 7) * 256 + 128 + (n & 127);
    u32x4 o;
    o.x = pack2(sm[(c * 8 + 0) * 129 + nn], sm[(c * 8 + 1) * 129 + nn]);
    o.y = pack2(sm[(c * 8 + 2) * 129 + nn], sm[(c * 8 + 3) * 129 + nn]);
    o.z = pack2(sm[(c * 8 + 4) * 129 + nn], sm[(c * 8 + 5) * 129 + nn]);
    o.w = pack2(sm[(c * 8 + 6) * 129 + nn], sm[(c * 8 + 7) * 129 + nn]);
    *(u32x4*)(dst + (size_t)np * ldd + kt * 64 + c * 8) = o;
  }
}

DEV void tr_load(const float* __restrict__ src, int lds_, int N, int kt, int nt, float4 (&v)[8]) {
  const int tid = opaque_tid();
#pragma unroll
  for (int i = 0; i < 8; ++i) {
    const int id = tid + i * 256;
    const int kk = id >> 5, n = nt * 128 + (id & 31) * 4;
    v[i] = make_float4(0.f, 0.f, 0.f, 0.f);
    if (n < N) {
      const f32x4nt* q_ = (const f32x4nt*)(src + (size_t)(kt * 64 + kk) * lds_ + n);
      const f32x4nt t_ = __builtin_nontemporal_load(q_);
      v[i] = make_float4(t_.x, t_.y, t_.z, t_.w);
    }
  }
}
DEV void tr_store(const float4 (&v)[8], bf16_t* __restrict__ dst, int ldd, int kt, int nt, int mode, float* sm) {
  const int tid = opaque_tid();
  __syncthreads();
#pragma unroll
  for (int i = 0; i < 8; ++i) {
    const int id = tid + i * 256;
    float* d = sm + (id >> 5) * 129 + (id & 31) * 4;
    d[0] = v[i].x; d[1] = v[i].y; d[2] = v[i].z; d[3] = v[i].w;
  }
  __syncthreads();
#pragma unroll
  for (int i = 0; i < 4; ++i) {
    const int id = tid + i * 256;
    const int nn = id >> 3, c = id & 7;
    const int n = nt * 128 + nn;
    int np = n;
    if (mode == 1) np = (n >> 7) * 256 + (n & 127);
    else if (mode == 2) np = (n >> 7) * 256 + 128 + (n & 127);
    u32x4 o;
    o.x = pack2(sm[(c * 8 + 0) * 129 + nn], sm[(c * 8 + 1) * 129 + nn]);
    o.y = pack2(sm[(c * 8 + 2) * 129 + nn], sm[(c * 8 + 3) * 129 + nn]);
    o.z = pack2(sm[(c * 8 + 4) * 129 + nn], sm[(c * 8 + 5) * 129 + nn]);
    o.w = pack2(sm[(c * 8 + 6) * 129 + nn], sm[(c * 8 + 7) * 129 + nn]);
    *(u32x4*)(dst + (size_t)np * ldd + kt * 64 + c * 8) = o;
  }
}

struct TrDesc { const float* src; bf16_t* dst; int K, N, Npad, ldd, mode; };
DEV TrDesc get_tr(const Params& p, int idx) {
  TrDesc d;
  char* ws = p.ws;
  if (idx < 12) {
    const int l = idx / 3, k = idx % 3;
    if (k == 0) { d.src = p.in[I_WGATE] + (size_t)l * 1024 * 2816; d.dst = (bf16_t*)(ws + WS_WGU) + (size_t)l * 5632 * 1024; d.K = 1024; d.N = 2816; d.Npad = 2816; d.ldd = 1024; d.mode = 1; }
    else if (k == 1) { d.src = p.in[I_WUP] + (size_t)l * 1024 * 2816; d.dst = (bf16_t*)(ws + WS_WGU) + (size_t)l * 5632 * 1024; d.K = 1024; d.N = 2816; d.Npad = 2816; d.ldd = 1024; d.mode = 2; }
    else { d.src = p.in[I_WDOWN] + (size_t)l * 2816 * 1024; d.dst = (bf16_t*)(ws + WS_WD) + (size_t)l * 1024 * 2816; d.K = 2816; d.N = 1024; d.Npad = 1024; d.ldd = 2816; d.mode = 0; }
  } else if (idx < 18) {
    const int e = (idx - 12) / 3, k = (idx - 12) % 3;
    if (k == 0) { d.src = p.in[I_WINE] + (size_t)e * 1024 * 2048; d.dst = (bf16_t*)(ws + WS_WINE) + (size_t)e * 2048 * 1024; d.K = 1024; d.N = 2048; d.Npad = 2048; d.ldd = 1024; d.mode = 0; }
    else if (k == 1) { d.src = p.in[I_WOUTE] + (size_t)e * 1024 * 1024; d.dst = (bf16_t*)(ws + WS_WOUTE) + (size_t)e * 1024 * 1024; d.K = 1024; d.N = 1024; d.Npad = 1024; d.ldd = 1024; d.mode = 0; }
    else { d.src = p.in[I_GLUW] + (size_t)e * 512 * 512; d.dst = (bf16_t*)(ws + WS_GLU) + (size_t)e * 512 * 512; d.K = 512; d.N = 512; d.Npad = 512; d.ldd = 512; d.mode = 0; }
  } else {
    const int o = (idx - 18) / 4, k = (idx - 18) % 4;
    if (k == 0) { d.src = p.in[I_WINO] + (size_t)o * 1024 * 416; d.dst = (bf16_t*)(ws + WS_WINO) + (size_t)o * 512 * 1024; d.K = 1024; d.N = 416; d.Npad = 512; d.ldd = 1024; d.mode = 0; }
    else if (k == 1) { d.src = p.in[I_WQUP] + (size_t)o * 256 * 1536; d.dst = (bf16_t*)(ws + WS_WQ) + (size_t)o * 1536 * 256; d.K = 256; d.N = 1536; d.Npad = 1536; d.ldd = 256; d.mode = 0; }
    else if (k == 2) { d.src = p.in[I_WKVUP] + (size_t)o * 128 * 2048; d.dst = (bf16_t*)(ws + WS_WKV) + (size_t)o * 2048 * 128; d.K = 128; d.N = 2048; d.Npad = 2048; d.ldd = 128; d.mode = 0; }
    else { d.src = p.in[I_WOUTO] + (size_t)o * 1024 * 1024; d.dst = (bf16_t*)(ws + WS_WOUTO) + (size_t)o * 1024 * 1024; d.K = 1024; d.N = 1024; d.Npad = 1024; d.ldd = 1024; d.mode = 0; }
  }
  return d;
}

DEV void mod_task(const Params& p, int task, float* sm) {
  const int tid = opaque_tid();
  const int l = task / 96, n0 = (task % 96) * 64;
  float* sc = sm;
  float* red = sm + 9 * 1024;
  __syncthreads();
  for (int i = tid; i < 9 * 1024; i += 256) {
    const int ci = i >> 10, k = i & 1023;
    const float v = (ci < 8) ? p.in[I_C][ci * 1024 + k] : p.in[I_CCTX][k];
    sc[i] = siluf(v);
  }
  __syncthreads();
  const int col = tid & 63, kq = tid >> 6;
  const float* W = p.in[I_WMOD] + (size_t)l * 1024 * 6144 + n0 + col;
  float a[9];
#pragma unroll
  for (int j = 0; j < 9; ++j) a[j] = 0.f;
  for (int k = kq * 256; k < kq * 256 + 256; k += 16) {
    float wv[16];
#pragma unroll
    for (int u = 0; u < 16; ++u) wv[u] = __builtin_nontemporal_load(W + (size_t)(k + u) * 6144);
#pragma unroll
    for (int u = 0; u < 16; u += 4)
#pragma unroll
      for (int j = 0; j < 9; ++j) {
        const float4 sv = *(const float4*)(sc + j * 1024 + k + u);
        a[j] += sv.x * wv[u] + sv.y * wv[u + 1] + sv.z * wv[u + 2] + sv.w * wv[u + 3];
      }
  }
#pragma unroll
  for (int j = 0; j < 9; ++j) red[(kq * 9 + j) * 64 + col] = a[j];
  __syncthreads();
  for (int i = tid; i < 9 * 64; i += 256) {
    const int j = i >> 6, c = i & 63;
    const float v = red[(0 * 9 + j) * 64 + c] + red[(1 * 9 + j) * 64 + c] + red[(2 * 9 + j) * 64 + c] + red[(3 * 9 + j) * 64 + c];
    float mv = v + p.in[I_BMOD][l * 6144 + n0 + c];
    const int sec = (n0 + c) >> 10, cc = (n0 + c) & 1023;
    if (sec == 1) mv = p.in[I_GPREMIX][l * 1024 + cc] * (1.f + mv);
    else if (sec == 2) mv = p.in[I_GPOSTMIX][l * 1024 + cc] * mv;
    else if (sec == 4) mv = p.in[I_GPREFFN][l * 1024 + cc] * (1.f + mv);
    else if (sec == 5) mv = p.in[I_GPOSTFFN][l * 1024 + cc] * mv;
    ((float*)(p.ws + WS_MOD))[(size_t)(l * 9 + j) * 6144 + n0 + c] = mv;
  }
}

DEV void s5_build_task(const Params& p, int task4, float* sm) {
  const int tid = opaque_tid();
  const int task = task4 >> 2, sub = task4 & 3;
  const int e = task >> 5, g = task & 31;
  float* apow = sm;
  float* bbs = apow + 2 * 17 * 64 * 2;
  float* cs = bbs + 2 * 64 * 16 * 2;
  float* fs = cs + 2 * 16 * 64 * 2;
  __syncthreads();
  if (tid < 128) {
    const int d = tid >> 6, pp = tid & 63;
    const int gi = (e * 2 + d) * 32 + g;
    const float lr = p.in[I_LAMRE][gi * 64 + pp], li = p.in[I_LAMIM][gi * 64 + pp];
    const float dt = expf(p.in[I_LOGDT][gi]);
    for (int tau = 0; tau <= 16; ++tau) {
      const float mag = expf((float)tau * lr * dt);
      double th = (double)tau * (double)li * (double)dt;
      th -= 6.283185307179586476925 * rint(th * 0.15915494309189533577);
      float sn, cn;
      sincosf((float)th, &sn, &cn);
      apow[((d * 17 + tau) * 64 + pp) * 2 + 0] = mag * cn;
      apow[((d * 17 + tau) * 64 + pp) * 2 + 1] = mag * sn;
      if (tau == 16 && sub == 0) {
        float* at = (float*)(p.ws + WS_AT) + ((size_t)gi * 64 + pp) * 2;
        at[0] = mag * cn; at[1] = mag * sn;
      }
      if (tau == 1) {
        const float are = mag * cn, aim = mag * sn;
        const float den = lr * lr + li * li;
        fs[(d * 64 + pp) * 2 + 0] = ((are - 1.f) * lr + aim * li) / den;
        fs[(d * 64 + pp) * 2 + 1] = (aim * lr - (are - 1.f) * li) / den;
      }
    }
  }
  __syncthreads();
  for (int i = tid; i < 2048; i += 256) {
    const int d = i >> 10, pp = (i >> 4) & 63, hi = i & 15;
    const size_t gi = (size_t)((e * 2 + d) * 32 + g);
    const float br = p.in[I_BRE][(gi * 64 + pp) * 16 + hi], bi = p.in[I_BIM][(gi * 64 + pp) * 16 + hi];
    const float fr = fs[(d * 64 + pp) * 2], fi = fs[(d * 64 + pp) * 2 + 1];
    bbs[i * 2 + 0] = fr * br - fi * bi;
    bbs[i * 2 + 1] = fr * bi + fi * br;
    const int ho = (i >> 6) & 15, p2 = i & 63;
    cs[i * 2 + 0] = p.in[I_CRE][(gi * 16 + ho) * 64 + p2];
    cs[i * 2 + 1] = p.in[I_CIM][(gi * 16 + ho) * 64 + p2];
  }
  __syncthreads();
  bf16_t* Gt = (bf16_t*)(p.ws + WS_GT) + (size_t)(e * 32 + g) * 65536;
  bf16_t* TEt = (bf16_t*)(p.ws + WS_TET) + (size_t)(e * 32 + g) * 131072;
  {
    const int s = tid >> 4, hi = tid & 15;
    for (int n = sub * 64; n < sub * 64 + 64; ++n) {
      const int d = n >> 7, ri = (n >> 6) & 1, pp = n & 63;
      const int pw = d == 0 ? 15 - s : s;
      const float ar = apow[((d * 17 + pw) * 64 + pp) * 2], ai = apow[((d * 17 + pw) * 64 + pp) * 2 + 1];
      const float br = bbs[((d * 64 + pp) * 16 + hi) * 2], bi = bbs[((d * 64 + pp) * 16 + hi) * 2 + 1];
      const float v = ri == 0 ? (ar * br - ai * bi) : (ar * bi + ai * br);
      Gt[n * 256 + tid] = f2bf(v);
    }
  }
  {
    const int d = tid >> 7, ri = (tid >> 6) & 1, pp = tid & 63;
    for (int n = sub * 64; n < sub * 64 + 64; ++n) {
      const int t = n >> 4, ho = n & 15;
      const int pw = d == 0 ? t + 1 : 16 - t;
      const float ar = apow[((d * 17 + pw) * 64 + pp) * 2], ai = apow[((d * 17 + pw) * 64 + pp) * 2 + 1];
      const float cr = cs[((d * 16 + ho) * 64 + pp) * 2], ci = cs[((d * 16 + ho) * 64 + pp) * 2 + 1];
      const float v = ri == 0 ? (cr * ar - ci * ai) : -(cr * ai + ci * ar);
      TEt[n * 512 + 256 + tid] = f2bf(v);
    }
  }
  {
    const int ho = tid >> 4, hi = tid & 15;
    for (int j = sub * 8; j < sub * 8 + 8; ++j) {
      const int d = j >> 4, tau = j & 15;
      if (d == 1 && tau == 0) continue;
      float v = 0.f;
      for (int pp = 0; pp < 64; ++pp) {
        const float cr = cs[((d * 16 + ho) * 64 + pp) * 2], ci = cs[((d * 16 + ho) * 64 + pp) * 2 + 1];
        const float ar = apow[((d * 17 + tau) * 64 + pp) * 2], ai = apow[((d * 17 + tau) * 64 + pp) * 2 + 1];
        const float br = bbs[((d * 64 + pp) * 16 + hi) * 2], bi = bbs[((d * 64 + pp) * 16 + hi) * 2 + 1];
        const float xr = cr * ar - ci * ai, xi = cr * ai + ci * ar;
        v += xr * br - xi * bi;
      }
      if (tau == 0) {
        for (int pp = 0; pp < 64; ++pp) {
          const float cr = cs[((16 + ho) * 64 + pp) * 2], ci = cs[((16 + ho) * 64 + pp) * 2 + 1];
          const float br = bbs[((64 + pp) * 16 + hi) * 2], bi = bbs[((64 + pp) * 16 + hi) * 2 + 1];
          v += cr * br - ci * bi;
        }
        if (ho == hi) v += p.in[I_S5D][e * 512 + g * 16 + ho];
        const bf16_t bv = f2bf(v);
        for (int t = 0; t < 16; ++t) TEt[(t * 16 + ho) * 512 + t * 16 + hi] = bv;
      } else if (d == 0) {
        const bf16_t bv = f2bf(v);
        for (int t = tau; t < 16; ++t) TEt[(t * 16 + ho) * 512 + (t - tau) * 16 + hi] = bv;
      } else {
        const bf16_t bv = f2bf(v);
        for (int t = 0; t < 16 - tau; ++t) TEt[(t * 16 + ho) * 512 + (t + tau) * 16 + hi] = bv;
      }
    }
  }
}

DEV void tr_run(const Params& p, unsigned dsel, int vb, int nvb, float* smf) {
  int total = 0;
  for (int di = 0; di < 26; ++di) if ((dsel >> di) & 1u) { const TrDesc d = get_tr(p, di); total += (d.K >> 6) * (d.Npad >> 7); }
  float4 vc[8], vn[8];
  TrDesc dc = get_tr(p, 0), dn = dc;
  int tc = 0, tn = 0;
  auto decode = [&](int gi, TrDesc& d, int& t) {
    int rem = gi;
    for (int di = 0; di < 26; ++di) {
      if (!((dsel >> di) & 1u)) continue;
      d = get_tr(p, di);
      const int cnt = (d.K >> 6) * (d.Npad >> 7);
      if (rem < cnt) break;
      rem -= cnt;
    }
    t = rem;
  };
  int gi = vb;
  if (gi < total) { decode(gi, dc, tc); const int ntn = dc.Npad >> 7; tr_load(dc.src, dc.N, dc.N, tc / ntn, tc % ntn, vc); }
  for (; gi < total; gi += nvb) {
    const int gn = gi + nvb;
    if (gn < total) { decode(gn, dn, tn); const int ntn = dn.Npad >> 7; tr_load(dn.src, dn.N, dn.N, tn / ntn, tn % ntn, vn); }
    { const int ntn = dc.Npad >> 7; tr_store(vc, dc.dst, dc.ldd, tc / ntn, tc % ntn, dc.mode, smf); }
#pragma unroll
    for (int i = 0; i < 8; ++i) vc[i] = vn[i];
    dc = dn; tc = tn;
  }
}
DEV unsigned tr_layer_mask(int l) {
  unsigned m = 7u << (3 * l);
  if ((l & 1) == 0) m |= 7u << (12 + 3 * (l >> 1));
  else m |= 15u << (18 + 4 * (l >> 1));
  return m;
}

DEV void phase0(const Params& p, float* smf) {
  const int tid = opaque_tid(), nb = VNB, bid = VBID;
  for (int t = bid; t < 256; t += nb) s5_build_task(p, t, smf);
  for (int t = (bid + nb - 256 % nb) % nb; t < 96; t += nb) mod_task(p, t, smf);
  {
    float* rd = (float*)(p.ws + WS_ROPED);
    float* rm = (float*)(p.ws + WS_ROPEM);
    for (int i = bid * 256 + tid; i < 1024 * 32 + 1024 * 16; i += nb * 256) {
      if (i < 1024 * 32) {
        const int pos = i >> 5, j = i & 31;
        const float base = (j < 16) ? (float)(pos >> 6) : (float)(pos & 63);
        const float inv = exp2f(-(float)(j & 15) * (13.287712379549449f / 16.f));
        float sn, cn;
        sincosf(base * inv, &sn, &cn);
        rd[i] = cn; rd[1024 * 32 + i] = sn;
      } else {
        const int ii = i - 1024 * 32;
        const int pos = ii >> 4, j = ii & 15;
        const float base = (j < 8) ? (float)(pos >> 6) : (float)(pos & 63);
        const float inv = exp2f(-(float)(j & 7) * (13.287712379549449f / 8.f));
        float sn, cn;
        sincosf(base * inv, &sn, &cn);
        rm[ii] = cn; rm[1024 * 16 + ii] = sn;
      }
    }
    if (bid == nb - 1 && tid < 2) {
      const int e = tid;
      float s1 = 0.f, s2 = 0.f;
      for (int i = 0; i < 64; ++i) {
        s1 += p.in[I_LQ1][e * 64 + i] * p.in[I_LK1][e * 64 + i];
        s2 += p.in[I_LQ2][e * 64 + i] * p.in[I_LK2][e * 64 + i];
      }
      const float lam_init = 0.8f - 0.6f * expf(-0.3f * (float)(2 * e));
      float* lv = (float*)(p.ws + WS_LAM);
      lv[e * 2 + 0] = expf(s1) - expf(s2) + lam_init;
      lv[e * 2 + 1] = lam_init;
    }
  }
  if (bid >= 352) tr_run(p, tr_layer_mask(0), bid - 352, nb - 352, smf);
}

DEV void row_phase(const Params& p, int mode, int l) {
  const int tid_ = opaque_tid();
  const int lane = tid_ & 63;
  const int gw = VBID * 4 + (tid_ >> 6), nw = VNB * 4;
  const float* mod = (const float*)(p.ws + WS_MOD);
  const bf16_t* Y = (const bf16_t*)(p.ws + WS_Y);
  const bf16_t* Y2 = (const bf16_t*)(p.ws + WS_Y2);
  bf16_t* H = (bf16_t*)(p.ws + WS_H);
  bf16_t* XB = (bf16_t*)(p.ws + WS_XB);
#define ROW_LOAD(M, X, YB, Y2B)                                                                         \
  {                                                                                                     \
    if (mode == 0 || (mode == 1 && l == 0)) {                                                           \
      const float* src_ = ((M) < NCTX ? p.in[I_XP] + (size_t)(M) * 1024 : p.in[I_XS] + (size_t)((M) - NCTX) * 1024); \
      _Pragma("unroll") for (int i = 0; i < 4; ++i) X[i] = *(const float4*)(src_ + i * 256 + lane * 4); \
    } else {                                                                                            \
      _Pragma("unroll") for (int i = 0; i < 4; ++i) {                                                   \
        const u32x2 xb_ = *(const u32x2*)(XB + (size_t)(M) * 1024 + i * 256 + lane * 4);                \
        X[i].x = __uint_as_float(xb_.x << 16); X[i].y = __uint_as_float(xb_.x & 0xffff0000u);           \
        X[i].z = __uint_as_float(xb_.y << 16); X[i].w = __uint_as_float(xb_.y & 0xffff0000u);           \
      }                                                                                                 \
    }                                                                                                   \
    if (mode != 0) {                                                                                    \
      _Pragma("unroll") for (int i = 0; i < 4; ++i)                                                     \
        YB[i] = *(const u32x2*)(Y + (size_t)(M) * 1024 + i * 256 + lane * 4);                           \
    }                                                                                                   \
  }
  float4 xc[4], xn[4];
  u32x2 yc[4], y2c[4], yn[4], y2n[4];
#pragma unroll
  for (int i = 0; i < 4; ++i) { yc[i] = mk2(0, 0); y2c[i] = mk2(0, 0); yn[i] = mk2(0, 0); y2n[i] = mk2(0, 0); xn[i] = make_float4(0.f, 0.f, 0.f, 0.f); }
  if (gw < NTOK) ROW_LOAD(gw, xc, yc, y2c)
  const bool last = (mode == 2 && l == 3);
  for (int m = gw; m < NTOK; m += nw) {
    const int mnext = m + nw;
    if (mnext < NTOK) ROW_LOAD(mnext, xn, yn, y2n)
    const int ci = m < NCTX ? 8 : ((m - NCTX) >> 10);
    const float* mr = mod + (size_t)(l * 9 + ci) * 6144;
    if (mode != 0) {
      const float* a1p = mr + (mode == 1 ? 2 : 5) * 1024;
      float4 a1[4];
#pragma unroll
      for (int i = 0; i < 4; ++i) a1[i] = *(const float4*)(a1p + i * 256 + lane * 4);
      float4 y[4];
      float ss = 0.f;
#pragma unroll
      for (int i = 0; i < 4; ++i) {
        y[i].x = __uint_as_float(yc[i].x << 16); y[i].y = __uint_as_float(yc[i].x & 0xffff0000u);
        y[i].z = __uint_as_float(yc[i].y << 16); y[i].w = __uint_as_float(yc[i].y & 0xffff0000u);
        if (false) {
          y[i].x += __uint_as_float(y2c[i].x << 16); y[i].y += __uint_as_float(y2c[i].x & 0xffff0000u);
          y[i].z += __uint_as_float(y2c[i].y << 16); y[i].w += __uint_as_float(y2c[i].y & 0xffff0000u);
        }
        ss += y[i].x * y[i].x + y[i].y * y[i].y + y[i].z * y[i].z + y[i].w * y[i].w;
      }
      ss = wave_sum(ss);
      const float rs = rsqrtf(ss * (1.f / 1024.f) + EPS);
#pragma unroll
      for (int i = 0; i < 4; ++i) {
        xc[i].x += a1[i].x * (y[i].x * rs);
        xc[i].y += a1[i].y * (y[i].y * rs);
        xc[i].z += a1[i].z * (y[i].z * rs);
        xc[i].w += a1[i].w * (y[i].w * rs);
      }
    }
    const float *a2p, *a3p;
    if (mode == 1) { a2p = mr + 4 * 1024; a3p = mr + 3 * 1024; }
    else {
      const int l2 = (mode == 0) ? 0 : (l + 1) & 3;
      const float* mr2 = mod + (size_t)(l2 * 9 + ci) * 6144;
      a2p = mr2 + 1024; a3p = mr2;
    }
    float4 a2[4], a3[4];
    if (!last) {
#pragma unroll
      for (int i = 0; i < 4; ++i) {
        a2[i] = *(const float4*)(a2p + i * 256 + lane * 4);
        a3[i] = *(const float4*)(a3p + i * 256 + lane * 4);
      }
    }
    if (last) {
#pragma unroll
      for (int i = 0; i < 4; ++i) { f32x4nt t_; t_.x = xc[i].x; t_.y = xc[i].y; t_.z = xc[i].z; t_.w = xc[i].w; __builtin_nontemporal_store(t_, (f32x4nt*)(p.out + (size_t)m * 1024 + i * 256 + lane * 4)); }
    } else if (mode != 0) {
#pragma unroll
      for (int i = 0; i < 4; ++i) {
        u32x2 o; o.x = pack2(xc[i].x, xc[i].y); o.y = pack2(xc[i].z, xc[i].w);
        *(u32x2*)(XB + (size_t)m * 1024 + i * 256 + lane * 4) = o;
      }
    }
    if (!last) {
      float ss2 = 0.f;
#pragma unroll
      for (int i = 0; i < 4; ++i) ss2 += xc[i].x * xc[i].x + xc[i].y * xc[i].y + xc[i].z * xc[i].z + xc[i].w * xc[i].w;
      ss2 = wave_sum(ss2);
      const float rs2 = rsqrtf(ss2 * (1.f / 1024.f) + EPS);
#pragma unroll
      for (int i = 0; i < 4; ++i) {
        u32x2 o;
        o.x = pack2(xc[i].x * rs2 * a2[i].x + a3[i].x, xc[i].y * rs2 * a2[i].y + a3[i].y);
        o.y = pack2(xc[i].z * rs2 * a2[i].z + a3[i].z, xc[i].w * rs2 * a2[i].w + a3[i].w);
        *(u32x2*)(H + (size_t)m * 1024 + i * 256 + lane * 4) = o;
      }
    }
#pragma unroll
    for (int i = 0; i < 4; ++i) { xc[i] = xn[i]; yc[i] = yn[i]; y2c[i] = y2n[i]; }
  }
#undef ROW_LOAD
}


DEV void even_cache_tasks(const Params& p, int e, float* smf, int bid, int nb) {
  const int tid = opaque_tid();
  bf16_t* KD = (bf16_t*)(p.ws + WS_KD);
  for (int i = bid * 256 + tid; i < 8 * 512 * 64; i += nb * 256) {
    const int row = i >> 6, c = i & 63;
    const int b = row >> 9, j = row & 511;
    const float* s = p.in[I_CDK] + ((size_t)(b * 2 + e) * 512 + j) * 512 + c * 8;
    const float4 v0 = *(const float4*)s, v1 = *(const float4*)(s + 4);
    u32x4 o; o.x = pack2(v0.x, v0.y); o.y = pack2(v0.z, v0.w); o.z = pack2(v1.x, v1.y); o.w = pack2(v1.z, v1.w);
    *(u32x4*)(KD + (size_t)(NCTX + b * 1536 + j) * 512 + c * 8) = o;
  }
  bf16_t* VL = (bf16_t*)(p.ws + WS_VTDL);
  for (int t = bid; t < 8 * 4 * 8; t += nb) {
    const int bh = t >> 3, kt = t & 7, nt = 0;
    const int b = bh >> 2, hh = bh & 3;
    const float* src = p.in[I_CDV] + (size_t)(b * 2 + e) * 512 * 512 + hh * 128;
    transpose_tile(src, 512, 128, VL + (size_t)(b * 4 + hh) * 128 * 1536, 1536, kt, nt, 0, smf);
  }
}

template <int DQK, int DV, int NKT, class KF>
DEV void flash_block(const bf16_t* __restrict__ qrow  , KF kptr,
                     const bf16_t* __restrict__ Vt, int ldv, int nkeys, float scale_log2, bf16_t* smem,
                     f32x16 (&O)[DV / 32], float& l_out) {
  int tid = threadIdx.x; asm volatile("" : "+v"(tid));
  const int lane = tid & 63, w = tid >> 6;
  const int r = lane & 31, h = lane >> 5;
  constexpr int KSTR = DQK + 8, VSTR = 68;
  constexpr int NKC = DQK / 8;
  constexpr int KTOT = NKT * 64 * NKC;
  constexpr int KCH = (KTOT + 511) / 512;
  constexpr int VCH = DV * 8 / 512;
  const bf16_t* sK = smem;
  const bf16_t* sV = smem + NKT * 64 * KSTR;
  const int cw = (NKT == 2) ? (w >> 2) : 0;
  bf16x8 qf[DQK / 16];
#pragma unroll
  for (int s = 0; s < DQK / 16; ++s) qf[s] = *(const bf16x8*)(qrow + s * 16 + h * 8);
  u32x4 rk[KCH], rv[VCH];
#pragma unroll
  for (int i = 0; i < KCH; ++i) rk[i] = mk4(0, 0, 0, 0);
  constexpr int BUFE = NKT * 64 * KSTR + DV * VSTR;
#define FL_LOAD(KEY0)                                                                   \
  {                                                                                     \
    _Pragma("unroll") for (int i = 0; i < KCH; ++i) {                                   \
      const int id = tid + i * 512;                                                     \
      const int c = id % NKC, row = (id / NKC) & 63, comp = id / (NKC * 64);            \
      if (id < KTOT) rk[i] = *(const u32x4*)kptr(comp, (KEY0) + row, c);                \
    }                                                                                   \
    _Pragma("unroll") for (int i = 0; i < VCH; ++i) {                                   \
      const int id = tid + i * 512;                                                     \
      rv[i] = *(const u32x4*)(Vt + (size_t)(id >> 3) * ldv + (KEY0) + (id & 7) * 8);    \
    }                                                                                   \
  }
#define FL_WRITE(BUF)                                                                   \
  {                                                                                     \
    bf16_t* sKw = smem + (BUF) * BUFE;                                                  \
    bf16_t* sVw = sKw + NKT * 64 * KSTR;                                                \
    _Pragma("unroll") for (int i = 0; i < KCH; ++i) {                                   \
      const int id = tid + i * 512;                                                     \
      const int c = id % NKC, row = (id / NKC) & 63, comp = id / (NKC * 64);            \
      if (id < KTOT) *(u32x4*)(sKw + (comp * 64 + row) * KSTR + c * 8) = rk[i];         \
    }                                                                                   \
    _Pragma("unroll") for (int i = 0; i < VCH; ++i) {                                   \
      const int id = tid + i * 512;                                                     \
      bf16_t* d = sVw + (id >> 3) * VSTR + (id & 7) * 8;                                \
      *(u32x2*)d = mk2(rv[i].x, rv[i].y);                                               \
      *(u32x2*)(d + 4) = mk2(rv[i].z, rv[i].w);                                         \
    }                                                                                   \
  }
  float m_run = -INFINITY, l_run = 0.f;
#pragma unroll
  for (int v = 0; v < DV / 32; ++v)
#pragma unroll
    for (int i = 0; i < 16; ++i) O[v][i] = 0.f;
  const int ntile = nkeys >> 6;
  FL_LOAD(0)
  FL_WRITE(0)
  if (ntile > 1) FL_LOAD(64)
  __syncthreads();
  for (int kt = 0; kt < ntile; ++kt) {
    if (kt + 1 < ntile) FL_WRITE((kt + 1) & 1)
    if (kt + 2 < ntile) FL_LOAD((kt + 2) << 6)
    sK = smem + (kt & 1) * BUFE;
    sV = sK + NKT * 64 * KSTR;
    f32x16 st[2];
#pragma unroll
    for (int kh = 0; kh < 2; ++kh)
#pragma unroll
      for (int i = 0; i < 16; ++i) st[kh][i] = 0.f;
#pragma unroll
    for (int s = 0; s < DQK / 16; ++s)
#pragma unroll
      for (int kh = 0; kh < 2; ++kh) {
        const bf16x8 kf = *(const bf16x8*)(sK + (cw * 64 + kh * 32 + r) * KSTR + s * 16 + h * 8);
        st[kh] = mfma(kf, qf[s], st[kh]);
      }
    float mx;
    {
      float m0 = fmaxf(fmaxf(st[0][0], st[0][1]), st[0][2]), m1 = fmaxf(fmaxf(st[1][0], st[1][1]), st[1][2]);
#pragma unroll
      for (int i = 3; i < 15; i += 2) { m0 = fmaxf(fmaxf(m0, st[0][i]), st[0][i + 1]); m1 = fmaxf(fmaxf(m1, st[1][i]), st[1][i + 1]); }
      mx = fmaxf(fmaxf(m0, m1), fmaxf(st[0][15], st[1][15]));
    }
    mx = fmaxf(mx, __shfl_xor(mx, 32));
    const float m_new = fmaxf(m_run, mx * scale_log2);
    const float alpha = fast_exp2(m_run - m_new);
    typedef float f32x2_t __attribute__((ext_vector_type(2)));
    f32x2_t ps2 = {0.f, 0.f};
    const f32x2_t sc2 = {scale_log2, scale_log2}, mn2 = {-m_new, -m_new};
#pragma unroll
    for (int kh = 0; kh < 2; ++kh)
#pragma unroll
      for (int i = 0; i < 16; i += 2) {
        f32x2_t v = {st[kh][i], st[kh][i + 1]};
        v = __builtin_elementwise_fma(v, sc2, mn2);
        f32x2_t e;
        e.x = fast_exp2(v.x); e.y = fast_exp2(v.y);
        ps2 += e;
        st[kh][i] = e.x; st[kh][i + 1] = e.y;
      }
    const float ps = ps2.x + ps2.y;
    l_run = l_run * alpha + ps;
    m_run = m_new;
    if (__builtin_amdgcn_ballot_w64(alpha != 1.f) != 0ull) {
#pragma unroll
      for (int v = 0; v < DV / 32; ++v)
#pragma unroll
        for (int i = 0; i < 16; ++i) O[v][i] *= alpha;
    }
#pragma unroll
    for (int kh = 0; kh < 2; ++kh)
#pragma unroll
      for (int s2 = 0; s2 < 2; ++s2) {
        union { u32x4 u; bf16x8 v; } pb;
        pb.u.x = pack2(st[kh][8 * s2 + 0], st[kh][8 * s2 + 1]);
        pb.u.y = pack2(st[kh][8 * s2 + 2], st[kh][8 * s2 + 3]);
        pb.u.z = pack2(st[kh][8 * s2 + 4], st[kh][8 * s2 + 5]);
        pb.u.w = pack2(st[kh][8 * s2 + 6], st[kh][8 * s2 + 7]);
#pragma unroll
        for (int v = 0; v < DV / 32; ++v) {
          const bf16_t* vp = sV + (v * 32 + r) * VSTR + kh * 32 + s2 * 16 + 4 * h;
          union { u32x4 u; bf16x8 v; } vf;
          const u32x2 lo = *(const u32x2*)vp, hi = *(const u32x2*)(vp + 8);
          vf.u = mk4(lo.x, lo.y, hi.x, hi.y);
          O[v] = mfma(vf.v, pb.v, O[v]);
        }
      }
    __syncthreads();
  }
  l_out = l_run + __shfl_xor(l_run, 32);
#undef FL_LOAD
#undef FL_WRITE
}

DEV void diff_attn_task(const Params& p, int e, int task, bf16_t* smem) {
  int t512 = threadIdx.x; asm volatile("" : "+v"(t512));
  const int lane = t512 & 63, w = t512 >> 6, r = lane & 31, h = lane >> 5;
  int b, hh, qb, mq0, keyrow0, nkeys, ldv;
  const bf16_t* Vt;
  if (task < 256) {
    b = task >> 5; hh = (task >> 3) & 3; qb = task & 7;
    mq0 = NCTX + b * 1024 + qb * 128; keyrow0 = NCTX + b * 1536; nkeys = 1536; ldv = 1536;
    Vt = (const bf16_t*)(p.ws + WS_VTDL) + (size_t)(b * 4 + hh) * 128 * 1536;
  } else {
    const int t2 = task - 256;
    b = t2 >> 3; hh = (t2 >> 1) & 3; qb = t2 & 1;
    mq0 = b * 256 + qb * 128; keyrow0 = b * 256; nkeys = 256; ldv = 256;
    Vt = (const bf16_t*)(p.ws + WS_VTDC) + (size_t)(b * 4 + hh) * 128 * 256;
  }
  const int cw = w >> 2, qw = (w & 3) * 32;
  const bf16_t* QD = (const bf16_t*)(p.ws + WS_QD);
  const bf16_t* KD = (const bf16_t*)(p.ws + WS_KD) + (size_t)keyrow0 * 512 + hh * 128;
  const int mq = mq0 + qw + r;
  f32x16 O[4];
  float l;
  flash_block<64, 128, 2>(QD + (size_t)mq * 512 + hh * 128 + cw * 64,
                          [&](int comp, int key, int c) { return KD + (size_t)key * 512 + comp * 64 + c * 8; },
                          Vt, ldv, nkeys, 0.125f * 1.4426950408889634f, smem, O, l);
  const float inv = 1.f / l;
  float* sO = (float*)smem;
  if (w >= 4) {
#pragma unroll
    for (int v = 0; v < 4; ++v)
#pragma unroll
      for (int i = 0; i < 16; ++i) {
        const int vd = v * 32 + (i & 3) + 8 * (i >> 2) + 4 * h;
        sO[((w - 4) * 128 + vd) * 32 + r] = O[v][i] * inv;
      }
  }
  __syncthreads();
  if (w < 4) {
    const float* lv = (const float*)(p.ws + WS_LAM);
    const float lam = lv[e * 2], lam_init = lv[e * 2 + 1];
    float ss = 0.f;
#pragma unroll
    for (int v = 0; v < 4; ++v)
#pragma unroll
      for (int i = 0; i < 16; ++i) {
        const int vd = v * 32 + (i & 3) + 8 * (i >> 2) + 4 * h;
        const float o = O[v][i] * inv - lam * sO[(w * 128 + vd) * 32 + r];
        O[v][i] = o;
        ss += o * o;
      }
    ss += __shfl_xor(ss, 32);
    const float rs = rsqrtf(ss * (1.f / 128.f) + EPS) * (1.f - lam_init);
    const float* sg = p.in[I_SUBLN] + e * 128;
    bf16_t* Yc = (bf16_t*)(p.ws + WS_YCAT) + (size_t)mq * 1024 + 512 + hh * 128;
#pragma unroll
    for (int v = 0; v < 4; ++v)
#pragma unroll
      for (int g4 = 0; g4 < 4; ++g4) {
        const int vd = v * 32 + 8 * g4 + 4 * h;
        const float4 gg = *(const float4*)(sg + vd);
        u32x2 o;
        o.x = pack2(O[v][g4 * 4 + 0] * rs * gg.x, O[v][g4 * 4 + 1] * rs * gg.y);
        o.y = pack2(O[v][g4 * 4 + 2] * rs * gg.z, O[v][g4 * 4 + 3] * rs * gg.w);
        *(u32x2*)(Yc + vd) = o;
      }
  }
  __syncthreads();
}

DEV void mla_attn_task(const Params& p, int task, bf16_t* smem) {
  int t512 = threadIdx.x; asm volatile("" : "+v"(t512));
  const int lane = t512 & 63, w = t512 >> 6, r = lane & 31, h = lane >> 5;
  int b, hd, qb, mq0, keyrow0, nkeys, ldv;
  const bf16_t* Vt;
  if (task < 512) {
    b = task >> 6; hd = (task >> 2) & 15; qb = task & 3;
    mq0 = NCTX + b * 1024 + qb * 256; keyrow0 = NCTX + b * 1536; nkeys = 1536; ldv = 1536;
    Vt = (const bf16_t*)(p.ws + WS_VTML) + (size_t)(b * 16 + hd) * 64 * 1536;
  } else {
    const int t2 = task - 512;
    b = t2 >> 4; hd = t2 & 15; qb = 0;
    mq0 = b * 256; keyrow0 = b * 256; nkeys = 256; ldv = 256;
    Vt = (const bf16_t*)(p.ws + WS_VTMC) + (size_t)(b * 16 + hd) * 64 * 256;
  }
  (void)qb;
  const bf16_t* QM = (const bf16_t*)(p.ws + WS_QM);
  const bf16_t* KN = (const bf16_t*)(p.ws + WS_KN) + (size_t)keyrow0 * 1024 + hd * 64;
  const bf16_t* KR = (const bf16_t*)(p.ws + WS_KRA) + (size_t)keyrow0 * 32;
  const int mq = mq0 + w * 32 + r;
  f32x16 O[2];
  float l;
  flash_block<96, 64, 1>(QM + (size_t)mq * 1536 + hd * 96,
                         [&](int comp, int key, int c) { return c < 8 ? KN + (size_t)key * 1024 + c * 8 : KR + (size_t)key * 32 + (c - 8) * 8; },
                         Vt, ldv, nkeys, 0.10206207261596575f * 1.4426950408889634f, smem, O, l);
  const float inv = 1.f / l;
  bf16_t* Yc = (bf16_t*)(p.ws + WS_YCAT) + (size_t)mq * 1024 + hd * 64;
#pragma unroll
  for (int v = 0; v < 2; ++v)
#pragma unroll
    for (int g4 = 0; g4 < 4; ++g4) {
      const int vd = v * 32 + 8 * g4 + 4 * h;
      u32x2 o;
      o.x = pack2(O[v][g4 * 4 + 0] * inv, O[v][g4 * 4 + 1] * inv);
      o.y = pack2(O[v][g4 * 4 + 2] * inv, O[v][g4 * 4 + 3] * inv);
      *(u32x2*)(Yc + vd) = o;
    }
}

DEV void s5_sgemm_tile(const Params& p, int e, int t, bf16_t* smem) {
  LANE_VARS
  const int g = t / 12, mt = (t % 12) >> 1, nt = t & 1;
  const int m0 = mt * 128, n0 = nt * 128;
  const bf16_t* Ug = (const bf16_t*)(p.ws + WS_UG) + (size_t)g * NTOK * 16;
  const bf16_t* Bt = (const bf16_t*)(p.ws + WS_GT) + (size_t)(e * 32 + g) * 65536 + (size_t)n0 * 256;
  f32x16 acc[2][2];
  gemm_mainloop([&](int row, int k) { return Ug + (size_t)(m0 + row) * 256 + k; }, Bt, 256, 256, smem, acc);
  float* S = (float*)(p.ws + WS_S) + (size_t)g * 768 * 256;
#pragma unroll
  for (int tm = 0; tm < 2; ++tm)
#pragma unroll
    for (int tn = 0; tn < 2; ++tn)
#pragma unroll
      for (int i = 0; i < 16; ++i)
        S[(size_t)(m0 + ACC_ROW(tm, i)) * 256 + n0 + wn * 64 + tn * 32 + r] = acc[tm][tn][i];
}

DEV void s5_scan_phase(const Params& p, int e) {
  const float* S = (const float*)(p.ws + WS_S);
  bf16_t* Hin = (bf16_t*)(p.ws + WS_HIN);
  for (int it = VBID * 256 + opaque_tid(); it < 24 * 4096; it += VNB * 256) {
    const int pp = it & 63, d = (it >> 6) & 1, g = (it >> 7) & 31, seq = it >> 12;
    int base, nc;
    float hr = 0.f, hi = 0.f;
    if (seq < 16) { base = seq * 16; nc = 16; }
    else {
      const int b = seq - 16; base = 256 + b * 64; nc = 64;
      const size_t si = ((size_t)((b * 2 + e) * 2 + d)) * 2048 + g * 64 + pp;
      hr = p.in[I_S5RE][si]; hi = p.in[I_S5IM][si];
    }
    const float* at = (const float*)(p.ws + WS_AT) + ((size_t)((e * 2 + d) * 32 + g) * 64 + pp) * 2;
    const float ar = at[0], ai = at[1];
    const size_t col = (size_t)d * 128 + pp;
    const float* Sg = S + (size_t)g * 768 * 256;
    bf16_t* Hg = Hin + (size_t)g * 768 * 256;
#pragma unroll 4
    for (int c = 0; c < nc; ++c) {
      const int row = base + (d == 0 ? c : nc - 1 - c);
      const float sr = Sg[(size_t)row * 256 + col], si = Sg[(size_t)row * 256 + col + 64];
      Hg[(size_t)row * 256 + col] = f2bf(hr);
      Hg[(size_t)row * 256 + col + 64] = f2bf(hi);
      const float nr = ar * hr - ai * hi + sr, ni = ar * hi + ai * hr + si;
      hr = nr; hi = ni;
    }
    if (seq < 16) {
      const size_t oi = ((size_t)((seq * 2 + e) * 2 + d)) * 2048 + g * 64 + pp;
      p.out[O_S5RE + oi] = hr;
      p.out[O_S5IM + oi] = hi;
    }
  }
}

DEV void s5_ygemm_tile(const Params& p, int e, int t, bf16_t* smem) {
  LANE_VARS
  const int g = t / 12, mt = (t % 12) >> 1, nt = t & 1;
  const int m0 = mt * 128, n0 = nt * 128;
  const bf16_t* Ug = (const bf16_t*)(p.ws + WS_UG) + (size_t)g * NTOK * 16;
  const bf16_t* Hg = (const bf16_t*)(p.ws + WS_HIN) + (size_t)g * 768 * 256;
  const bf16_t* Bt = (const bf16_t*)(p.ws + WS_TET) + (size_t)(e * 32 + g) * 131072 + (size_t)n0 * 512;
  f32x16 acc[2][2];
  gemm_mainloop([&](int row, int k) { return k < 256 ? Ug + (size_t)(m0 + row) * 256 + k : Hg + (size_t)(m0 + row) * 256 + (k - 256); },
                Bt, 512, 512, smem, acc);
  bf16_t* G = (bf16_t*)(p.ws + WS_G);
#pragma unroll
  for (int tm = 0; tm < 2; ++tm)
#pragma unroll
    for (int tn = 0; tn < 2; ++tn)
#pragma unroll
      for (int i = 0; i < 16; ++i) {
        const int m = m0 + ACC_ROW(tm, i), n = n0 + wn * 64 + tn * 32 + r;
        const int tok = m * 16 + (n >> 4);
        G[(size_t)tok * 512 + g * 16 + (n & 15)] = f2bf(gelu_tanh(acc[tm][tn][i]));
      }
}

DEV void glu_tile(const Params& p, int e, int t, bf16_t* smem) {
  LANE_VARS
  const int mt = t >> 2, nt = t & 3;
  const int m0 = mt * 128, n0 = nt * 128;
  const bf16_t* G = (const bf16_t*)(p.ws + WS_G);
  const bf16_t* Bt = (const bf16_t*)(p.ws + WS_GLU) + (size_t)e * 512 * 512 + (size_t)n0 * 512;
  f32x16 acc[2][2];
  gemm_mainloop([&](int row, int k) { return G + (size_t)(m0 + row) * 512 + k; }, Bt, 512, 512, smem, acc);
  bf16_t* Yc = (bf16_t*)(p.ws + WS_YCAT);
  const float* gb = p.in[I_GLUB] + e * 512;
#pragma unroll
  for (int tm = 0; tm < 2; ++tm)
#pragma unroll
    for (int tn = 0; tn < 2; ++tn) {
      const int n = n0 + wn * 64 + tn * 32 + r;
      const float bias = gb[n];
#pragma unroll
      for (int i = 0; i < 16; ++i) {
        const int m = m0 + ACC_ROW(tm, i);
        const float gv = bf2f(G[(size_t)m * 512 + n]);
        Yc[(size_t)m * 1024 + n] = f2bf(gv * sigmoidf(acc[tm][tn][i] + bias));
      }
    }
}


DEV void odd_inproj_tile(const Params& p, int o, int t, bf16_t* smem) {
  LANE_VARS
  const int mt = t >> 2, nt = t & 3;
  const int m0 = mt * 128, n0 = nt * 128;
  const bf16_t* H = (const bf16_t*)(p.ws + WS_H);
  const bf16_t* Bt = (const bf16_t*)(p.ws + WS_WINO) + (size_t)o * 512 * 1024 + (size_t)n0 * 1024;
  f32x16 acc[2][2];
  gemm_mainloop([&](int row, int k) { return H + (size_t)(m0 + row) * 1024 + k; }, Bt, 1024, 1024, smem, acc);
  float* PR = (float*)(p.ws + WS_PROJO);
#pragma unroll
  for (int tm = 0; tm < 2; ++tm)
#pragma unroll
    for (int tn = 0; tn < 2; ++tn)
#pragma unroll
      for (int i = 0; i < 16; ++i) {
        const int m = m0 + ACC_ROW(tm, i), n = n0 + wn * 64 + tn * 32 + r;
        if (n < 416) PR[(size_t)m * 416 + n] = acc[tm][tn][i];
      }
}

DEV void odd_cache_rows(const Params& p, int o, int vb, int nvb) {
  bf16_t* CKVA = (bf16_t*)(p.ws + WS_CKVA);
  bf16_t* KRA = (bf16_t*)(p.ws + WS_KRA);
  for (int i = vb * 256 + opaque_tid(); i < 8 * 512 * 16; i += nvb * 256) {
    const int row = i >> 4, c = i & 15;
    const int b = row >> 9, j = row & 511;
    const float* s = p.in[I_CCKV] + ((size_t)(b * 2 + o) * 512 + j) * 128 + c * 8;
    const float4 v0 = *(const float4*)s, v1 = *(const float4*)(s + 4);
    u32x4 ov; ov.x = pack2(v0.x, v0.y); ov.y = pack2(v0.z, v0.w); ov.z = pack2(v1.x, v1.y); ov.w = pack2(v1.z, v1.w);
    *(u32x4*)(CKVA + (size_t)(NCTX + b * 1536 + j) * 128 + c * 8) = ov;
    if (c < 4) {
      const float* s2 = p.in[I_CKR] + ((size_t)(b * 2 + o) * 512 + j) * 32 + c * 8;
      const float4 w0 = *(const float4*)s2, w1 = *(const float4*)(s2 + 4);
      u32x4 ok; ok.x = pack2(w0.x, w0.y); ok.y = pack2(w0.z, w0.w); ok.z = pack2(w1.x, w1.y); ok.w = pack2(w1.z, w1.w);
      *(u32x4*)(KRA + (size_t)(NCTX + b * 1536 + j) * 32 + c * 8) = ok;
    }
  }
}
DEV void odd_row_phase(const Params& p, int o) {
  const int tid_ = opaque_tid();
  const int lane = tid_ & 63;
  const int gw = VBID * 4 + (tid_ >> 6), nw = VNB * 4;
  const float* PR = (const float*)(p.ws + WS_PROJO);
  bf16_t* CQ = (bf16_t*)(p.ws + WS_CQ);
  bf16_t* CKVA = (bf16_t*)(p.ws + WS_CKVA);
  bf16_t* KRA = (bf16_t*)(p.ws + WS_KRA);
  const float* rc = (const float*)(p.ws + WS_ROPEM);
  const float* rsn = rc + 1024 * 16;
  const float4 gq = *(const float4*)(p.in[I_QNORM] + o * 256 + lane * 4);
  const float2 gk = *(const float2*)(p.in[I_KVNORM] + o * 128 + lane * 2);
  float4 q4 = make_float4(0.f, 0.f, 0.f, 0.f), q4n = q4;
  float2 k2 = make_float2(0.f, 0.f), k2n = k2;
  float krv = 0.f, krvn = 0.f;
  if (gw < NTOK) {
    const float* row = PR + (size_t)gw * 416;
    q4 = *(const float4*)(row + lane * 4);
    k2 = *(const float2*)(row + 256 + lane * 2);
    if (lane < 32) krv = row[384 + lane];
  }
  for (int m = gw; m < NTOK; m += nw) {
    if (m + nw < NTOK) {
      const float* rown = PR + (size_t)(m + nw) * 416;
      q4n = *(const float4*)(rown + lane * 4);
      k2n = *(const float2*)(rown + 256 + lane * 2);
      if (lane < 32) krvn = rown[384 + lane];
    }
    float ss = q4.x * q4.x + q4.y * q4.y + q4.z * q4.z + q4.w * q4.w;
    ss = wave_sum(ss);
    const float rq = rsqrtf(ss * (1.f / 256.f) + EPS);
    u32x2 oq;
    oq.x = pack2(q4.x * rq * gq.x, q4.y * rq * gq.y);
    oq.y = pack2(q4.z * rq * gq.z, q4.w * rq * gq.w);
    *(u32x2*)(CQ + (size_t)m * 256 + lane * 4) = oq;
    float sk = k2.x * k2.x + k2.y * k2.y;
    sk = wave_sum(sk);
    const float rk = rsqrtf(sk * (1.f / 128.f) + EPS);
    const float c0 = k2.x * rk * gk.x, c1 = k2.y * rk * gk.y;
    const bool lat = m >= NCTX;
    const int pos = (m - NCTX) & 1023;
    const size_t keyrow = lat ? (size_t)(NCTX + ((m - NCTX) >> 10) * 1536 + 512 + pos) : (size_t)m;
    *(uint32_t*)(CKVA + keyrow * 128 + lane * 2) = pack2(c0, c1);
    const float partner = __shfl_xor(krv, 16);
    if (!lat) {
      const int b = m >> 8, j = m & 255;
      *(float2*)(p.out + O_CKV + ((size_t)(b * 2 + o) * 256 + j) * 128 + lane * 2) = make_float2(c0, c1);
      if (lane < 32) {
        p.out[O_KR + ((size_t)(b * 2 + o) * 256 + j) * 32 + lane] = krv;
        KRA[keyrow * 32 + lane] = f2bf(krv);
      }
    } else if (lane < 32) {
      const float c = rc[pos * 16 + (lane & 15)], s = rsn[pos * 16 + (lane & 15)];
      const float v = (lane & 16) ? (krv * c + partner * s) : (krv * c - partner * s);
      KRA[keyrow * 32 + lane] = f2bf(v);
    }
    q4 = q4n; k2 = k2n; krv = krvn;
  }
}

DEV void qup_tile(const Params& p, int o, int t, bf16_t* smem) {
  LANE_VARS
  const int mt = t / 12, nt = t % 12;
  const int m0 = mt * 128, n0 = nt * 128;
  const bf16_t* CQ = (const bf16_t*)(p.ws + WS_CQ);
  const bf16_t* Bt = (const bf16_t*)(p.ws + WS_WQ) + (size_t)o * 1536 * 256 + (size_t)n0 * 256;
  f32x16 acc[2][2];
  gemm_mainloop([&](int row, int k) { return CQ + (size_t)(m0 + row) * 256 + k; }, Bt, 256, 256, smem, acc);
  bf16_t* QM = (bf16_t*)(p.ws + WS_QM);
  const float* rc = (const float*)(p.ws + WS_ROPEM);
  const float* rsn = rc + 1024 * 16;
  const bool lat = m0 >= NCTX;
#pragma unroll
  for (int tn = 0; tn < 2; ++tn) {
    const int nb32 = (n0 >> 5) + wn * 2 + tn;
    const bool rope = lat && (nb32 % 3 == 2);
    const int n = nb32 * 32 + r;
#pragma unroll
    for (int tm = 0; tm < 2; ++tm)
#pragma unroll
      for (int i = 0; i < 16; ++i) {
        const int m = m0 + ACC_ROW(tm, i);
        float v = acc[tm][tn][i];
        if (rope) {
          const float partner = __shfl_xor(v, 16);
          const int pos = (m - NCTX) & 1023;
          const float c = rc[pos * 16 + (r & 15)], s = rsn[pos * 16 + (r & 15)];
          v = (r & 16) ? (v * c + partner * s) : (v * c - partner * s);
        }
        QM[(size_t)m * 1536 + n] = f2bf(v);
      }
  }
}

DEV void kvup_task(const Params& p, int o, int task, bf16_t* smem) {
  LANE_VARS
  const int mt = task >> 2, hq = task & 3;
  const int m0 = mt * 128;
  const bf16_t* CK = (const bf16_t*)(p.ws + WS_CKVA) + (size_t)m0 * 128;
  const bf16_t* W = (const bf16_t*)(p.ws + WS_WKV) + (size_t)o * 2048 * 128;
  bf16_t* sA = smem;
  bf16_t* sB = smem + 2 * 9216;
  const int kc = tid & 7, lr = tid >> 3;
  u32x4 rb[8];
  {
    u32x4 ra[8];
#pragma unroll
    for (int kt = 0; kt < 2; ++kt)
#pragma unroll
      for (int i = 0; i < 4; ++i) {
        ra[kt * 4 + i] = *(const u32x4*)(CK + (size_t)(lr + 32 * i) * 128 + kt * 64 + kc * 8);
        rb[kt * 4 + i] = *(const u32x4*)(W + (size_t)((hq * 4) * 128 + lr + 32 * i) * 128 + kt * 64 + kc * 8);
      }
#pragma unroll
    for (int kt = 0; kt < 2; ++kt)
#pragma unroll
      for (int i = 0; i < 4; ++i) {
        *(u32x4*)(sA + kt * 9216 + (lr + 32 * i) * 72 + kc * 8) = ra[kt * 4 + i];
        *(u32x4*)(sB + kt * 9216 + (lr + 32 * i) * 72 + kc * 8) = rb[kt * 4 + i];
      }
  }
  __syncthreads();
  const bool lat = m0 >= NCTX;
  for (int j = 0; j < 4; ++j) {
    const int hd = hq * 4 + j;
    if (j + 1 < 4) {
#pragma unroll
      for (int kt = 0; kt < 2; ++kt)
#pragma unroll
        for (int i = 0; i < 4; ++i)
          rb[kt * 4 + i] = *(const u32x4*)(W + (size_t)((hd + 1) * 128 + lr + 32 * i) * 128 + kt * 64 + kc * 8);
    }
    f32x16 acc[2][2];
#pragma unroll
    for (int a = 0; a < 2; ++a)
#pragma unroll
      for (int b = 0; b < 2; ++b)
#pragma unroll
        for (int i = 0; i < 16; ++i) acc[a][b][i] = 0.f;
#pragma unroll
    for (int kt = 0; kt < 2; ++kt)
#pragma unroll
      for (int ks = 0; ks < 4; ++ks) {
        const bf16x8 a0 = *(const bf16x8*)(sA + kt * 9216 + (wm * 64 + r) * 72 + ks * 16 + h * 8);
        const bf16x8 a1 = *(const bf16x8*)(sA + kt * 9216 + (wm * 64 + 32 + r) * 72 + ks * 16 + h * 8);
        const bf16x8 b0 = *(const bf16x8*)(sB + kt * 9216 + (wn * 64 + r) * 72 + ks * 16 + h * 8);
        const bf16x8 b1 = *(const bf16x8*)(sB + kt * 9216 + (wn * 64 + 32 + r) * 72 + ks * 16 + h * 8);
        acc[0][0] = mfma(a0, b0, acc[0][0]);
        acc[0][1] = mfma(a0, b1, acc[0][1]);
        acc[1][0] = mfma(a1, b0, acc[1][0]);
        acc[1][1] = mfma(a1, b1, acc[1][1]);
      }
    if (wn == 0) {
      bf16_t* KN = (bf16_t*)(p.ws + WS_KN);
#pragma unroll
      for (int tm = 0; tm < 2; ++tm)
#pragma unroll
        for (int tn = 0; tn < 2; ++tn)
#pragma unroll
          for (int i = 0; i < 16; ++i)
            KN[(size_t)(m0 + ACC_ROW(tm, i)) * 1024 + hd * 64 + tn * 32 + r] = f2bf(acc[tm][tn][i]);
    } else {
#pragma unroll
      for (int tm = 0; tm < 2; ++tm)
#pragma unroll
        for (int tn = 0; tn < 2; ++tn) {
          const int vd = tn * 32 + r;
#pragma unroll
          for (int g4 = 0; g4 < 4; ++g4) {
            const int m4 = m0 + wm * 64 + tm * 32 + 8 * g4 + 4 * h;
            u32x2 ov;
            ov.x = pack2(acc[tm][tn][g4 * 4 + 0], acc[tm][tn][g4 * 4 + 1]);
            ov.y = pack2(acc[tm][tn][g4 * 4 + 2], acc[tm][tn][g4 * 4 + 3]);
            bf16_t* dst;
            if (!lat) { const int b = m4 >> 8, jj = m4 & 255; dst = (bf16_t*)(p.ws + WS_VTMC) + ((size_t)(b * 16 + hd) * 64 + vd) * 256 + jj; }
            else { const int mm = m4 - NCTX; const int b = mm / 1536, jj = mm % 1536; dst = (bf16_t*)(p.ws + WS_VTML) + ((size_t)(b * 16 + hd) * 64 + vd) * 1536 + jj; }
            *(u32x2*)dst = ov;
          }
        }
    }
    __syncthreads();
    if (j + 1 < 4) {
#pragma unroll
      for (int kt = 0; kt < 2; ++kt)
#pragma unroll
        for (int i = 0; i < 4; ++i) *(u32x4*)(sB + kt * 9216 + (lr + 32 * i) * 72 + kc * 8) = rb[kt * 4 + i];
    }
    __syncthreads();
  }
}

namespace pg8 {
#define PG8_LAS __attribute__((address_space(3)))
typedef short sbf16x8 __attribute__((ext_vector_type(8)));
typedef float f32x4 __attribute__((ext_vector_type(4)));
constexpr int BM = 256, BK = 64, HALF = 128, HTB = HALF * BK * 2, STAGE_BYTES = 8 * HTB, NXCD = 8, WGM = 8;
DEV int lds_byte(int r, int c) { const int st = (r >> 4) * 2 + (c >> 5), rr = r & 15, cc = c & 31, ob = rr * 64 + cc * 2; return st * 1024 + (ob ^ (((ob >> 9) & 1) << 5)); }
DEV void stage_rc(int b, int& R, int& C) { const int st = b / 1024, sb = b % 1024, swz = sb ^ (((sb >> 9) & 1) << 5); R = (st >> 1) * 16 + swz / 64; C = (st & 1) * 32 + (swz % 64) / 2; }
DEV int perm32(int rho) { const int n = rho >> 4, i = rho & 15; return 8 * (i >> 2) + 4 * n + (i & 3); }
DEV int perm_rope(int R) { return 64 * (R >> 6) + 32 * ((R >> 4) & 1) + 16 * ((R >> 5) & 1) + (R & 15); }
struct Unit { int pm, pn; };
struct Gemm { const bf16_t* A; const bf16_t* Bt; int M, N, K; };
struct StaticOrder {
  int nM, nN, nwg, G, c;
  DEV void init(int M, int N, int G_, int c_) { nM = M / BM; nN = N / BM; nwg = nM * nN; G = G_; c = c_; }
  DEV bool next(int i, Unit& u) const {
    const long L = (long)i * G + c; if (L >= nwg) return false;
    int wgid = (int)L; { const int q = nwg / NXCD, r = nwg % NXCD, xcd = wgid % NXCD, off = wgid / NXCD; wgid = (xcd < r ? xcd * (q + 1) : r * (q + 1) + (xcd - r) * q) + off; }
    const int nig = WGM * nN, gid = wgid / nig, fm = gid * WGM, gsz = (nM - fm) < WGM ? (nM - fm) : WGM;
    u.pm = fm + ((wgid % nig) % gsz); u.pn = (wgid % nig) / gsz; return true;
  }
};
struct EpiGateUp {
  static constexpr int PERMID = 1;
  bf16_t* ACT;
  DEV void operator()(const f32x4 (&acc)[2][2][4][2], const Unit& u, int wr, int wc, int fr, int fq) const {
    const int row0 = u.pm * BM + wr * 64 + fr, col0 = u.pn * 128 + wc * 32 + 8 * fq;
#pragma unroll
    for (int ai = 0; ai < 2; ++ai)
#pragma unroll
      for (int m = 0; m < 4; ++m) {
        const f32x4 g0 = acc[ai][0][m][0], g1 = acc[ai][0][m][1], v0 = acc[ai][1][m][0], v1 = acc[ai][1][m][1];
        u32x4 w;
        w.x = pack2(siluf(g0[0]) * v0[0], siluf(g0[1]) * v0[1]);
        w.y = pack2(siluf(g0[2]) * v0[2], siluf(g0[3]) * v0[3]);
        w.z = pack2(siluf(g1[0]) * v1[0], siluf(g1[1]) * v1[1]);
        w.w = pack2(siluf(g1[2]) * v1[2], siluf(g1[3]) * v1[3]);
        *(u32x4*)(ACT + (size_t)(row0 + ai * HALF + m * 16) * 2816 + col0) = w;
      }
  }
};
struct EpiY {
  static constexpr int PERMID = 1;
  bf16_t* O;
  DEV void operator()(const f32x4 (&acc)[2][2][4][2], const Unit& u, int wr, int wc, int fr, int fq) const {
    const int row0 = u.pm * BM + wr * 64 + fr, col0 = u.pn * BM + wc * 32 + 8 * fq;
#pragma unroll
    for (int ai = 0; ai < 2; ++ai)
#pragma unroll
      for (int m = 0; m < 4; ++m) {
        bf16_t* rowp = O + (size_t)(row0 + ai * HALF + m * 16) * 1024 + col0;
#pragma unroll
        for (int bj = 0; bj < 2; ++bj) {
          const f32x4 v0 = acc[ai][bj][m][0], v1 = acc[ai][bj][m][1];
          u32x4 w; w.x = pack2(v0[0], v0[1]); w.y = pack2(v0[2], v0[3]); w.z = pack2(v1[0], v1[1]); w.w = pack2(v1[2], v1[3]);
          *(u32x4*)(rowp + bj * HALF) = w;
        }
      }
  }
};
struct EpiInEven {
  static constexpr int PERMID = 2;
  bf16_t *Ug, *QD, *KD; float* out_dk; const float* rc; int e;
  DEV void operator()(const f32x4 (&acc)[2][2][4][2], const Unit& u, int wr, int wc, int fr, int fq) const {
    const int region = u.pn >> 1;
    const bool lat = u.pm >= (NCTX / 256);
    const float* rsn = rc + 1024 * 32;
#pragma unroll
    for (int ai = 0; ai < 2; ++ai)
#pragma unroll
      for (int m = 0; m < 4; ++m) {
        const int row = u.pm * BM + ai * HALF + wr * 64 + m * 16 + fr;
        const int pos = (row - NCTX) & 1023;
#pragma unroll
        for (int bj = 0; bj < 2; ++bj) {
          const int cb = (u.pn & 1) * 256 + bj * 128 + 64 * (wc >> 1) + 16 * (wc & 1) + 4 * fq;
          const f32x4 a0 = acc[ai][bj][m][0], a1 = acc[ai][bj][m][1];
          if (region == 0) {
            u32x2 w0, w1;
            w0.x = pack2(a0[0], a0[1]); w0.y = pack2(a0[2], a0[3]);
            w1.x = pack2(a1[0], a1[1]); w1.y = pack2(a1[2], a1[3]);
            *(u32x2*)(Ug + ((size_t)(cb >> 4) * NTOK + row) * 16 + (cb & 15)) = w0;
            *(u32x2*)(Ug + ((size_t)((cb + 32) >> 4) * NTOK + row) * 16 + (cb & 15)) = w1;
          } else {
            f32x4 o0 = a0, o1 = a1;
            if (lat) {
              const int d0 = cb & 63;
              const f32x4 c4 = *(const f32x4*)(rc + pos * 32 + d0), s4 = *(const f32x4*)(rsn + pos * 32 + d0);
              o0 = a0 * c4 - a1 * s4; o1 = a1 * c4 + a0 * s4;
            }
            u32x2 w0, w1;
            w0.x = pack2(o0[0], o0[1]); w0.y = pack2(o0[2], o0[3]);
            w1.x = pack2(o1[0], o1[1]); w1.y = pack2(o1[2], o1[3]);
            if (region == 1) {
              *(u32x2*)(QD + (size_t)row * 512 + cb) = w0;
              *(u32x2*)(QD + (size_t)row * 512 + cb + 32) = w1;
            } else {
              const size_t keyrow = lat ? (size_t)(NCTX + ((row - NCTX) >> 10) * 1536 + 512 + pos) : (size_t)row;
              *(u32x2*)(KD + keyrow * 512 + cb) = w0;
              *(u32x2*)(KD + keyrow * 512 + cb + 32) = w1;
              if (!lat) {
                float* o = out_dk + ((size_t)((row >> 8) * 2 + e) * 256 + (row & 255)) * 512 + cb;
                __builtin_nontemporal_store(a0, (f32x4*)o); __builtin_nontemporal_store(a1, (f32x4*)(o + 32));
              }
            }
          }
        }
      }
  }
};
struct EpiVt {
  static constexpr int PERMID = 1;
  bf16_t *VC, *VL; float* out_dv; int e;
  DEV void operator()(const f32x4 (&acc)[2][2][4][2], const Unit& u, int wr, int wc, int fr, int fq) const {
#pragma unroll
    for (int ai = 0; ai < 2; ++ai)
#pragma unroll
      for (int m = 0; m < 4; ++m) {
        const int vdt = u.pm * BM + ai * HALF + wr * 64 + m * 16 + fr;
        const int hh = vdt >> 7, vd = vdt & 127;
#pragma unroll
        for (int bj = 0; bj < 2; ++bj) {
          const int t0 = u.pn * BM + bj * HALF + wc * 32 + 8 * fq;
          const f32x4 v0 = acc[ai][bj][m][0], v1 = acc[ai][bj][m][1];
          u32x4 w; w.x = pack2(v0[0], v0[1]); w.y = pack2(v0[2], v0[3]); w.z = pack2(v1[0], v1[1]); w.w = pack2(v1[2], v1[3]);
          if (t0 < NCTX) {
            const int b = t0 >> 8, j0 = t0 & 255;
            *(u32x4*)(VC + ((size_t)(b * 4 + hh) * 128 + vd) * 256 + j0) = w;
            float* o = out_dv + ((size_t)(b * 2 + e) * 256 + j0) * 512 + vdt;
            __builtin_nontemporal_store(v0[0], o); __builtin_nontemporal_store(v0[1], o + 512); __builtin_nontemporal_store(v0[2], o + 1024); __builtin_nontemporal_store(v0[3], o + 1536);
            __builtin_nontemporal_store(v1[0], o + 2048); __builtin_nontemporal_store(v1[1], o + 2560); __builtin_nontemporal_store(v1[2], o + 3072); __builtin_nontemporal_store(v1[3], o + 3584);
          } else {
            const int mm = t0 - NCTX;
            const int b = mm >> 10, j0 = 512 + (mm & 1023);
            *(u32x4*)(VL + ((size_t)(b * 4 + hh) * 128 + vd) * 1536 + j0) = w;
          }
        }
      }
  }
};
template <class Epi>
DEV void gemm_phase(PG8_LAS unsigned char* lds, const Gemm g, const StaticOrder& S, const Epi& E) {
  int tid = threadIdx.x; asm volatile("" : "+v"(tid));
  const int wid = __builtin_amdgcn_readfirstlane(tid >> 6), lane = tid & 63, wr = wid >> 2, wc = wid & 3, fr = lane & 15, fq = lane >> 4;
  const int K = g.K, nt = K / BK;
  unsigned voffA[2], voffB[2];
#pragma unroll
  for (int i = 0; i < 2; ++i) { int R, C; stage_rc(tid * 16 + i * 8192, R, C); const int Rb = Epi::PERMID == 1 ? ((R & ~31) + perm32(R & 31)) : (Epi::PERMID == 2 ? perm_rope(R) : R);
    voffA[i] = (unsigned)(R * K + C) * 2u; voffB[i] = (unsigned)(Rb * K + C) * 2u; }
  const size_t kstep = (size_t)(BK * 2);
  const size_t hstep = (size_t)HALF * K * 2;
  const size_t tstep = 2 * hstep;
  const unsigned ldsw = (unsigned)wid * 1024u;
  const int aoff = lds_byte(wr * 64 + fr, fq * 8), boff = lds_byte(wc * 32 + fr, fq * 8);
#define PG8_SA(b, h) (((b) * 2 + (h)) * HTB)
#define PG8_SB(b, h) ((4 + (b) * 2 + (h)) * HTB)
#define PG8_STAGE(bufoff, gbase, voff) do { _Pragma("unroll") for (int _i = 0; _i < 2; ++_i) \
    __builtin_amdgcn_global_load_lds((const unsigned*)((const char*)(gbase) + (voff)[_i]), (PG8_LAS unsigned*)(lds + (bufoff) + ldsw + _i * 8192), 16, 0, 0); } while (0)
#define PG8_LDA(dst, b, h) do { _Pragma("unroll") for (int m = 0; m < 4; ++m) _Pragma("unroll") for (int k = 0; k < 2; ++k) dst[m][k] = *(const PG8_LAS sbf16x8*)(lds + PG8_SA(b, h) + aoff + m * 2048 + k * 1024); } while (0)
#define PG8_LDB(dst, b, h) do { _Pragma("unroll") for (int n = 0; n < 2; ++n) _Pragma("unroll") for (int k = 0; k < 2; ++k) dst[n][k] = *(const PG8_LAS sbf16x8*)(lds + PG8_SB(b, h) + boff + n * 2048 + k * 1024); } while (0)
#define PG8_MMA(ai, bj, At, Bt) do { __builtin_amdgcn_s_setprio(1); _Pragma("unroll") for (int m = 0; m < 4; ++m) _Pragma("unroll") for (int n = 0; n < 2; ++n) _Pragma("unroll") for (int k = 0; k < 2; ++k) \
    acc[ai][bj][m][n] = __builtin_amdgcn_mfma_f32_16x16x32_bf16(__builtin_bit_cast(bf16x8, Bt[n][k]), __builtin_bit_cast(bf16x8, At[m][k]), acc[ai][bj][m][n], 0, 0, 0); __builtin_amdgcn_s_setprio(0); } while (0)
#define PG8_WAIT_V(n) asm volatile("s_waitcnt vmcnt(" #n ")" ::: "memory")
#define PG8_WAIT_L(n) asm volatile("s_waitcnt lgkmcnt(" #n ")" ::: "memory")
#define PG8_BAR __builtin_amdgcn_s_barrier()
#define PG8_SCHED __builtin_amdgcn_sched_barrier(0)
  Unit cur, nxt; int ui = 0;
  if (!S.next(0, cur)) return;
  f32x4 acc[2][2][4][2];
#pragma unroll
  for (int a = 0; a < 2; ++a)
#pragma unroll
    for (int b = 0; b < 2; ++b)
#pragma unroll
      for (int m = 0; m < 4; ++m)
#pragma unroll
        for (int n = 0; n < 2; ++n) acc[a][b][m][n] = (f32x4){0.f, 0.f, 0.f, 0.f};
  sbf16x8 At[4][2], B0[2][2], B1[2][2];
  const char* cA = (const char*)g.A + (size_t)cur.pm * tstep; const char* cB = (const char*)g.Bt + (size_t)cur.pn * tstep;
  PG8_STAGE(PG8_SB(0, 0), cB, voffB); PG8_STAGE(PG8_SA(0, 0), cA, voffA); PG8_STAGE(PG8_SB(0, 1), cB + hstep, voffB); PG8_STAGE(PG8_SA(0, 1), cA + hstep, voffA);
  if (wr == 1) PG8_BAR;
  PG8_WAIT_V(4); PG8_BAR;
  PG8_STAGE(PG8_SB(1, 0), cB + kstep, voffB); PG8_STAGE(PG8_SA(1, 0), cA + kstep, voffA); PG8_STAGE(PG8_SB(1, 1), cB + hstep + kstep, voffB);
  PG8_WAIT_V(6); PG8_BAR;
  for (;;) {
    const bool has_next = S.next(ui + 1, nxt);
    const char* nA = has_next ? (const char*)g.A + (size_t)nxt.pm * tstep : cA; const char* nB = has_next ? (const char*)g.Bt + (size_t)nxt.pn * tstep : cB;
    for (int t = 0; t < nt; t += 2) {
      const bool last = (t == nt - 2);
      const char* a1 = cA + (size_t)(t + 1) * kstep;
      const char* a2 = last ? nA : cA + (size_t)(t + 2) * kstep; const char* b2 = last ? nB : cB + (size_t)(t + 2) * kstep;
      const char* a3 = a2 + kstep; const char* b3 = b2 + kstep;
      PG8_LDB(B0, 0, 0); PG8_SCHED; PG8_LDA(At, 0, 0); PG8_STAGE(PG8_SA(1, 1), a1 + hstep, voffA);
      PG8_WAIT_L(8); PG8_BAR; PG8_WAIT_L(0); PG8_MMA(0, 0, At, B0); PG8_BAR; PG8_SCHED;
      PG8_LDB(B1, 0, 1); PG8_STAGE(PG8_SB(0, 0), b2, voffB);
      PG8_BAR; PG8_WAIT_L(0); PG8_MMA(0, 1, At, B1); PG8_BAR;
      PG8_LDA(At, 0, 1); PG8_STAGE(PG8_SA(0, 0), a2, voffA);
      PG8_BAR; PG8_WAIT_L(0); PG8_MMA(1, 0, At, B0); PG8_BAR; PG8_SCHED;
      PG8_STAGE(PG8_SB(0, 1), b2 + hstep, voffB);
      PG8_WAIT_V(6); PG8_BAR; PG8_MMA(1, 1, At, B1); PG8_BAR;
      PG8_LDB(B0, 1, 0); PG8_SCHED; PG8_LDA(At, 1, 0); PG8_STAGE(PG8_SA(0, 1), a2 + hstep, voffA);
      PG8_WAIT_L(8); PG8_BAR; PG8_WAIT_L(0); PG8_MMA(0, 0, At, B0); PG8_BAR; PG8_SCHED;
      PG8_LDB(B1, 1, 1); PG8_STAGE(PG8_SB(1, 0), b3, voffB);
      PG8_BAR; PG8_WAIT_L(0); PG8_MMA(0, 1, At, B1); PG8_BAR;
      PG8_LDA(At, 1, 1); PG8_STAGE(PG8_SA(1, 0), a3, voffA);
      PG8_BAR; PG8_WAIT_L(0); PG8_MMA(1, 0, At, B0); PG8_BAR; PG8_SCHED;
      PG8_STAGE(PG8_SB(1, 1), b3 + hstep, voffB);
      PG8_WAIT_V(6); PG8_BAR; PG8_MMA(1, 1, At, B1); PG8_BAR;
    }
    E(acc, cur, wr, wc, fr, fq);
    if (!has_next) break;
#pragma unroll
    for (int a = 0; a < 2; ++a)
#pragma unroll
      for (int b = 0; b < 2; ++b)
#pragma unroll
        for (int m = 0; m < 4; ++m)
#pragma unroll
          for (int n = 0; n < 2; ++n) acc[a][b][m][n] = (f32x4){0.f, 0.f, 0.f, 0.f};
    cur = nxt; cA = nA; cB = nB; ++ui;
  }
  PG8_WAIT_V(0);
  if (wr == 0) PG8_BAR;
  PG8_BAR;
#undef PG8_SA
#undef PG8_SB
#undef PG8_STAGE
#undef PG8_LDA
#undef PG8_LDB
#undef PG8_MMA
#undef PG8_WAIT_V
#undef PG8_WAIT_L
#undef PG8_BAR
#undef PG8_SCHED
}
}

#define XB_TMO      128
#define XB_XCNT(j)  (256  + 64 * (j))
#define XB_XSUB(j)  (1280 + 64 * (j))
#define XB_XGEN(j)  (2304 + 64 * (j))
#define XB_TOP      3328
#define XB_TOPGEN   3392
#define XCD_BAR_WORDS 3456
#define XB_SPIN_CAP (1u << 18)
#define LAS __attribute__((address_space(3)))
DEV unsigned xb_ld(unsigned* p) { return __hip_atomic_load(p, __ATOMIC_RELAXED, __HIP_MEMORY_SCOPE_AGENT); }
DEV unsigned xb_add(unsigned* p, unsigned v) { return __hip_atomic_fetch_add(p, v, __ATOMIC_RELAXED, __HIP_MEMORY_SCOPE_AGENT); }
DEV unsigned xb_xcc_id() { return (unsigned)__builtin_amdgcn_s_getreg((3 << 11) | 20) & 0xFu; }
#define XB_SPIN(cond, bar) do { unsigned _sp = 0; while (cond) { __builtin_amdgcn_s_sleep(1); \
    if ((++_sp & 255u) == 0u) { if (xb_ld(&(bar)[XB_TMO])) break; if (_sp > XB_SPIN_CAP) { atomicAdd(&(bar)[XB_TMO], 1u); break; } } } } while (0)
struct XcdBarrier { unsigned* bar; unsigned x; volatile LAS unsigned* st; };
DEV XcdBarrier xcd_barrier_post(unsigned* bar, volatile LAS unsigned* st) {
  XcdBarrier b; b.bar = bar; b.x = xb_xcc_id(); b.st = st;
  if (threadIdx.x == 0) (void)xb_add(&bar[XB_XCNT(b.x)], 1u);
  return b;
}
DEV void xcd_barrier_complete(unsigned* bar, unsigned x, unsigned& nloc, unsigned& nx) {
  const unsigned G = gridDim.x * gridDim.y * gridDim.z;
  unsigned sum, cnt, mine, sp = 0u;
  for (;;) {
    sum = 0u; cnt = 0u; mine = 0u;
#pragma unroll
    for (unsigned j = 0; j < 16; ++j) { const unsigned c = xb_ld(&bar[XB_XCNT(j)]); sum += c; cnt += (c > 0u) ? 1u : 0u; mine = (j == x) ? c : mine; }
    if (sum == G) break;
    __builtin_amdgcn_s_sleep(1);
    if ((++sp & 255u) == 0u) { if (xb_ld(&bar[XB_TMO])) break; if (sp > XB_SPIN_CAP) { atomicAdd(&bar[XB_TMO], 1u); break; } }
  }
  nloc = mine > 0u ? mine : 1u; nx = cnt > 0u ? cnt : 1u;
}
DEV void xcd_barrier(const XcdBarrier& b0) {
  XcdBarrier b = b0;
  asm volatile("" : "+s"(b.bar));
  b.x = xb_xcc_id();
  asm volatile("s_waitcnt vmcnt(0)" ::: "memory");
  __syncthreads();
  if (threadIdx.x == 0) {
    unsigned* bar = b.bar;
    __builtin_amdgcn_s_waitcnt(0);
    unsigned nloc = b.st[0], nx = b.st[1];
    if (nloc == 0u) { xcd_barrier_complete(bar, b.x, nloc, nx); b.st[0] = nloc; b.st[1] = nx; }
    const unsigned old = xb_add(&bar[XB_XSUB(b.x)], 1u);
    const unsigned gen = old / nloc;
    if (old + 1u == (gen + 1u) * nloc) {
      __builtin_amdgcn_fence(__ATOMIC_RELEASE, "agent");
      asm volatile("s_waitcnt vmcnt(0)" ::: "memory");
      const unsigned og = xb_add(&bar[XB_TOP], 1u);
      const unsigned tg = og / nx;
      if (og + 1u == (tg + 1u) * nx) xb_add(&bar[XB_TOPGEN], 1u);
      else XB_SPIN(xb_ld(&bar[XB_TOPGEN]) == tg, bar);
      __builtin_amdgcn_fence(__ATOMIC_ACQUIRE, "agent");
      xb_add(&bar[XB_XGEN(b.x)], 1u);
      asm volatile("s_waitcnt vmcnt(0)" ::: "memory");
    } else {
      XB_SPIN(xb_ld(&bar[XB_XGEN(b.x)]) == gen, bar);
      __builtin_amdgcn_fence(__ATOMIC_ACQUIRE, "agent");
      asm volatile("s_waitcnt vmcnt(0)" ::: "memory");
    }
  }
  __syncthreads();
}

__global__ void __launch_bounds__(512, 2) mega_kernel(Params p0) {
  Params p = p0;
#define PH_REFRESH { char* w_ = p0.ws; asm volatile("" : "+s"(w_)); p.ws = w_; float* o_ = p0.out; asm volatile("" : "+s"(o_)); p.out = o_; }
  __shared__ __attribute__((aligned(16))) char smem_raw[SMEM_BYTES];
  const int vhalf = __builtin_amdgcn_readfirstlane(threadIdx.x >> 8);
  bf16_t* smem = (bf16_t*)(smem_raw + vhalf * SMEM_VB);
  float* smf = (float*)(smem_raw + vhalf * SMEM_VB);
  PG8_LAS unsigned char* lds8 = (PG8_LAS unsigned char*)smem_raw;
  u32x4& xb_words = *(u32x4*)(smem_raw + 2 * SMEM_VB);
  cg::grid_group grid = cg::this_grid();
  const int bid = VBID, nb = VNB;
  if (threadIdx.x == 0) { u32x4 z; z.x = 0; z.y = 0; z.z = 0; z.w = 0; xb_words = z; }
  __syncthreads();
  const XcdBarrier xb = xcd_barrier_post((unsigned*)(p.ws + WS_BAR), (volatile LAS unsigned*)&xb_words);
  if (p0.ws == nullptr) grid.sync();

  phase0(p, smf);
  xcd_barrier(xb);
 PH_REFRESH
  row_phase(p, 0, 0);
  xcd_barrier(xb);
 PH_REFRESH

  for (int l = 0; l < 4; ++l) {
    if ((l & 1) == 0) {
      const int e = l >> 1;
      { pg8::StaticOrder S; S.init(NTOK, 1536, (int)gridDim.x, (int)blockIdx.x);
        pg8::gemm_phase(lds8, pg8::Gemm{(const bf16_t*)(p.ws + WS_H), (const bf16_t*)(p.ws + WS_WINE) + (size_t)e * 2048 * 1024, NTOK, 1536, 1024}, S,
                        pg8::EpiInEven{(bf16_t*)(p.ws + WS_UG), (bf16_t*)(p.ws + WS_QD), (bf16_t*)(p.ws + WS_KD), p.out + O_DK, (const float*)(p.ws + WS_ROPED), e});
        pg8::StaticOrder S2; S2.init(512, NTOK, (int)gridDim.x, (int)((blockIdx.x + 128) & 255));
        pg8::gemm_phase(lds8, pg8::Gemm{(const bf16_t*)(p.ws + WS_WINE) + (size_t)e * 2048 * 1024 + (size_t)1536 * 1024, (const bf16_t*)(p.ws + WS_H), 512, NTOK, 1024}, S2,
                        pg8::EpiVt{(bf16_t*)(p.ws + WS_VTDC), (bf16_t*)(p.ws + WS_VTDL), p.out + O_DV, e}); }
      {
        const int c = (int)blockIdx.x;
        const int sel = (c >= 32 && c < 128) ? c - 32 : (c >= 224 ? 96 + (c - 224) : -1);
        if (sel >= 0) even_cache_tasks(p, e, smf, 2 * sel + (bid & 1), 256);
      }
      xcd_barrier(xb);
 PH_REFRESH
      for (int it = (int)blockIdx.x; it < 384 + 192; it += (int)gridDim.x) {
        const int task = it < 256 ? (((it & 7) * 4 + (it >> 6)) * 8 + ((it >> 3) & 7)) : it;
        if (it < 384) diff_attn_task(p, e, task, (bf16_t*)smem_raw);
        else {
          const int b_ = (int)blockIdx.x;
          const int lp = it < 512 ? (b_ >> 3) - 16 : 16 + (b_ >> 3);
          s5_sgemm_tile(p, e, 2 * ((b_ & 7) * 24 + lp) + (bid & 1), smem);
        }
      }
      xcd_barrier(xb);
 PH_REFRESH
      s5_scan_phase(p, e);
      xcd_barrier(xb);
 PH_REFRESH
      {
        const int lv = ((int)blockIdx.x >> 3) * 2 + (bid & 1);
        if (lv < 48) s5_ygemm_tile(p, e, (((int)blockIdx.x & 7) * 4 + lv / 12) * 12 + lv % 12, smem);
      }
      xcd_barrier(xb);
 PH_REFRESH
      {
        const int lv = ((int)blockIdx.x >> 3) * 2 + (bid & 1);
        if (lv < 48) glu_tile(p, e, (((int)blockIdx.x & 7) * 12 + (lv >> 2)) * 4 + (lv & 3), smem);
      }
      xcd_barrier(xb);
 PH_REFRESH
      { pg8::StaticOrder S; S.init(NTOK, 1024, (int)gridDim.x, (int)blockIdx.x);
        pg8::gemm_phase(lds8, pg8::Gemm{(const bf16_t*)(p.ws + WS_YCAT), (const bf16_t*)(p.ws + WS_WOUTE) + (size_t)e * 1024 * 1024, NTOK, 1024, 1024}, S, pg8::EpiY{(bf16_t*)(p.ws + WS_Y)}); }
      xcd_barrier(xb);
 PH_REFRESH
    } else {
      const int o = l >> 1;
      {
        const int lv = ((int)blockIdx.x >> 3) * 2 + (bid & 1);
        if (lv < 48) odd_inproj_tile(p, o, (((int)blockIdx.x & 7) * 12 + (lv >> 2)) * 4 + (lv & 3), smem);
        else odd_cache_rows(p, o, ((int)blockIdx.x & 7) * 16 + (lv - 48), 128);
      }
      xcd_barrier(xb);
 PH_REFRESH
      odd_row_phase(p, o);
      xcd_barrier(xb);
 PH_REFRESH
      {
        const int x = (int)blockIdx.x & 7, lv = ((int)blockIdx.x >> 3) * 2 + (bid & 1);
        kvup_task(p, o, (x * 16 + (lv >> 2)) * 4 + (lv & 3), smem);
        for (int idx = lv; idx < 144; idx += 64) qup_tile(p, o, (x * 12 + idx / 12) * 12 + idx % 12, smem);
      }
      xcd_barrier(xb);
 PH_REFRESH
      for (int t = (int)blockIdx.x; t < 768; t += (int)gridDim.x) {
        const int bl = t & 255;
        const int task = t < 512 ? ((((t >> 8) * 64 + (bl & 7) * 8 + (bl >> 5)) * 4) + ((bl >> 3) & 3)) : t;
        mla_attn_task(p, task, (bf16_t*)smem_raw);
      }
      xcd_barrier(xb);
 PH_REFRESH
      { pg8::StaticOrder S; S.init(NTOK, 1024, (int)gridDim.x, (int)blockIdx.x);
        pg8::gemm_phase(lds8, pg8::Gemm{(const bf16_t*)(p.ws + WS_YCAT), (const bf16_t*)(p.ws + WS_WOUTO) + (size_t)o * 1024 * 1024, NTOK, 1024, 1024}, S, pg8::EpiY{(bf16_t*)(p.ws + WS_Y)}); }
      xcd_barrier(xb);
 PH_REFRESH
    }
    row_phase(p, 1, l);
    xcd_barrier(xb);
 PH_REFRESH
    { pg8::StaticOrder S; S.init(NTOK, 5632, (int)gridDim.x, (int)blockIdx.x);
      pg8::gemm_phase(lds8, pg8::Gemm{(const bf16_t*)(p.ws + WS_H), (const bf16_t*)(p.ws + WS_WGU) + (size_t)l * 5632 * 1024, NTOK, 5632, 1024}, S, pg8::EpiGateUp{(bf16_t*)(p.ws + WS_ACT)}); }
    if (l < 3 && blockIdx.x >= 32) tr_run(p, tr_layer_mask(l + 1), bid - 64, nb - 64, smf);
    xcd_barrier(xb);
 PH_REFRESH
    { pg8::StaticOrder S; S.init(NTOK, 1024, (int)gridDim.x, (int)blockIdx.x);
      pg8::gemm_phase(lds8, pg8::Gemm{(const bf16_t*)(p.ws + WS_ACT), (const bf16_t*)(p.ws + WS_WD) + (size_t)l * 1024 * 2816, NTOK, 1024, 2816}, S, pg8::EpiY{(bf16_t*)(p.ws + WS_Y)}); }
    if (l < 3 && blockIdx.x >= 192) {
      for (int t = bid - 384; t < 96; t += 128) mod_task(p, (l + 1) * 96 + t, smf);
    }
    xcd_barrier(xb);
 PH_REFRESH
    row_phase(p, 2, l);
    if (l < 3) xcd_barrier(xb);
 PH_REFRESH
  }
}

extern "C" void kernel_launch(void* const* d_in, const int* in_sizes, int n_in, void* d_out, int out_size,
                              void* d_ws, size_t ws_size, hipStream_t stream) {
  const int grid_blocks = 256;
  Params p{};
  for (int i = 0; i < 42; ++i) p.in[i] = (const float*)d_in[i];
  p.out = (float*)d_out;
  p.ws = (char*)d_ws;
  (void)hipMemsetAsync((char*)d_ws + WS_BAR, 0, XCD_BAR_WORDS * 4, stream);
  void* args[] = {&p};
  hipError_t err = hipLaunchCooperativeKernel((void*)mega_kernel, dim3(grid_blocks), dim3(512), args, 0, stream);
  if (err != hipSuccess) fprintf(stderr, "cooperative launch failed: %s (grid %d)\n", hipGetErrorString(err), grid_blocks);
}
```

```cpp
#include <hip/hip_runtime.h>
#include <hip/hip_cooperative_groups.h>
#include <stdint.h>
#include <stdio.h>
namespace cg = cooperative_groups;

typedef unsigned short bf16_t;
typedef __attribute__((ext_vector_type(8))) __bf16 bf16x8;
typedef __attribute__((ext_vector_type(16))) float f32x16;
typedef __attribute__((ext_vector_type(4))) unsigned int u32x4;
typedef __attribute__((ext_vector_type(2))) unsigned int u32x2;
typedef __attribute__((ext_vector_type(4))) float f32x4nt;
#define DEV __device__ __forceinline__

constexpr int NTOK = 12288;
constexpr int NCTX = 4096;
constexpr float EPS = 1e-6f;

constexpr size_t O_S5RE = 12582912, O_S5IM = 12713984, O_DK = 12845056, O_DV = 17039360,
                 O_CKV = 21233664, O_KR = 22282240;

constexpr size_t al(size_t x) { return (x + 255) & ~size_t(255); }
constexpr size_t WS_MOD   = 0;
constexpr size_t WS_ROPED = WS_MOD + al(4 * 9 * 6144 * 4);
constexpr size_t WS_ROPEM = WS_ROPED + al(2 * 1024 * 32 * 4);
constexpr size_t WS_LAM   = WS_ROPEM + al(2 * 1024 * 16 * 4);
constexpr size_t WS_AT    = WS_LAM + 256;
constexpr size_t WS_GT    = WS_AT + al(2 * 2 * 32 * 64 * 2 * 4);
constexpr size_t WS_TET   = WS_GT + (size_t)2 * 32 * 256 * 256 * 2;
constexpr size_t WS_WGU   = WS_TET + (size_t)2 * 32 * 256 * 512 * 2;
constexpr size_t WS_WD    = WS_WGU + (size_t)4 * 5632 * 1024 * 2;
constexpr size_t WS_WINE  = WS_WD + (size_t)4 * 1024 * 2816 * 2;
constexpr size_t WS_WOUTE = WS_WINE + (size_t)2 * 2048 * 1024 * 2;
constexpr size_t WS_GLU   = WS_WOUTE + (size_t)2 * 1024 * 1024 * 2;
constexpr size_t WS_WINO  = WS_GLU + (size_t)2 * 512 * 512 * 2;
constexpr size_t WS_WQ    = WS_WINO + (size_t)2 * 512 * 1024 * 2;
constexpr size_t WS_WKV   = WS_WQ + (size_t)2 * 1536 * 256 * 2;
constexpr size_t WS_WOUTO = WS_WKV + (size_t)2 * 2048 * 128 * 2;
constexpr size_t WS_H     = WS_WOUTO + (size_t)2 * 1024 * 1024 * 2;
constexpr size_t WS_YCAT  = WS_H + (size_t)NTOK * 1024 * 2;
constexpr size_t WS_Y     = WS_YCAT + (size_t)NTOK * 1024 * 2;
constexpr size_t WS_MIX   = WS_Y + (size_t)NTOK * 1024 * 2;
constexpr size_t WS_ACT   = WS_MIX;
constexpr size_t WS_UG    = WS_MIX;
constexpr size_t WS_QD    = WS_UG + (size_t)NTOK * 512 * 2;
constexpr size_t WS_KD    = WS_QD + (size_t)NTOK * 512 * 2;
constexpr size_t WS_VTDC  = WS_KD + (size_t)16384 * 512 * 2;
constexpr size_t WS_VTDL  = WS_VTDC + (size_t)16 * 4 * 128 * 256 * 2;
constexpr size_t WS_S     = WS_VTDL + (size_t)8 * 4 * 128 * 1536 * 2;
constexpr size_t WS_HIN   = WS_S + (size_t)32 * 768 * 256 * 4;
constexpr size_t WS_G     = WS_HIN + (size_t)32 * 768 * 256 * 2;
constexpr size_t WS_PROJO = WS_MIX;
constexpr size_t WS_CQ    = WS_PROJO + (size_t)NTOK * 416 * 4;
constexpr size_t WS_QM    = WS_CQ + (size_t)NTOK * 256 * 2;
constexpr size_t WS_KN    = WS_QM + (size_t)NTOK * 1536 * 2;
constexpr size_t WS_VTMC  = WS_KN + (size_t)16384 * 1024 * 2;
constexpr size_t WS_VTML  = WS_VTMC + (size_t)16 * 16 * 64 * 256 * 2;
constexpr size_t WS_CKVA  = WS_VTML + (size_t)8 * 16 * 64 * 1536 * 2;
constexpr size_t WS_KRA   = WS_CKVA + (size_t)16384 * 128 * 2;
constexpr size_t WS_END   = WS_KRA + (size_t)16384 * 32 * 2;

constexpr size_t WS_BAR   = al(WS_END);
constexpr size_t WS_Y2    = al(WS_BAR + 3456 * 4);
constexpr size_t WS_XB    = al(WS_Y2 + 256);
constexpr int SMEM_VB = 73728;
constexpr int SMEM_BYTES = 2 * SMEM_VB + 16;

struct Params {
  const float* in[42];
  float* out;
  char* ws;
};

enum { I_XP = 0, I_XS, I_S5RE, I_S5IM, I_CDK, I_CDV, I_CCKV, I_CKR, I_C, I_CCTX, I_WMOD, I_BMOD,
       I_GPREMIX, I_GPOSTMIX, I_GPREFFN, I_GPOSTFFN, I_WGATE, I_WUP, I_WDOWN, I_WINE, I_WOUTE,
       I_LAMRE, I_LAMIM, I_LOGDT, I_BRE, I_BIM, I_CRE, I_CIM, I_S5D, I_GLUW, I_GLUB,
       I_LQ1, I_LK1, I_LQ2, I_LK2, I_SUBLN, I_WINO, I_QNORM, I_WQUP, I_KVNORM, I_WKVUP, I_WOUTO };

typedef __bf16 hbf16x2 __attribute__((ext_vector_type(2)));
typedef float f32x2v __attribute__((ext_vector_type(2)));
DEV uint32_t pack2(float a, float b) {
  const f32x2v v = {a, b};
  return __builtin_bit_cast(uint32_t, __builtin_convertvector(v, hbf16x2));
}
DEV bf16_t f2bf(float f) { return (bf16_t)(pack2(f, f) & 0xffffu); }
DEV u32x2 mk2(unsigned a, unsigned b) { u32x2 v; v.x = a; v.y = b; return v; }
DEV u32x4 mk4(unsigned a, unsigned b, unsigned c, unsigned d) { u32x4 v; v.x = a; v.y = b; v.z = c; v.w = d; return v; }
DEV float bf2f(bf16_t b) { return __uint_as_float((uint32_t)b << 16); }
DEV int opaque_tid() { int t = threadIdx.x & 255; asm volatile("" : "+v"(t)); return t; }
#define VBID ((int)(blockIdx.x * 2 + __builtin_amdgcn_readfirstlane(threadIdx.x >> 8)))
#define VNB ((int)(gridDim.x * 2))
DEV float wave_sum(float v) {
#pragma unroll
  for (int o = 32; o >= 1; o >>= 1) v += __shfl_xor(v, o);
  return v;
}
DEV float fast_exp2(float x) { return __builtin_amdgcn_exp2f(x); }
DEV float sigmoidf(float x) { return __builtin_amdgcn_rcpf(1.f + fast_exp2(-1.4426950408889634f * x)); }
DEV float siluf(float x) { return x * sigmoidf(x); }
DEV float gelu_tanh(float x) {
  float u = 0.7978845608028654f * (x + 0.044715f * x * x * x);
  float t = 1.f - 2.f * __builtin_amdgcn_rcpf(fast_exp2(2.8853900817779268f * u) + 1.f);
  return 0.5f * x * (1.f + t);
}
DEV f32x16 mfma(bf16x8 a, bf16x8 b, f32x16 c) { return __builtin_amdgcn_mfma_f32_32x32x16_bf16(a, b, c, 0, 0, 0); }

template <class AF>
DEV void gemm_mainloop(AF aptr, const bf16_t* __restrict__ Bt, int ldb, int K, bf16_t* smem, f32x16 (&acc)[2][2]) {
  const int tid = opaque_tid(), lane = tid & 63, w = tid >> 6;
  const int r = lane & 31, h = lane >> 5, wm = w >> 1, wn = w & 1;
  const int kc = tid & 7, lr = tid >> 3;
  u32x4 ra0[4], rb0[4], ra1[4], rb1[4];
  const int wofs = lr * 72 + kc * 8;
  const int aofs = (wm * 64 + r) * 72 + h * 8;
  const int bofs = 9216 + (wn * 64 + r) * 72 + h * 8;
#define GLOAD(RA, RB, K0)                                                              \
  _Pragma("unroll") for (int i = 0; i < 4; ++i) {                                      \
    RA[i] = *(const u32x4*)aptr(lr + 32 * i, (K0) + kc * 8);                           \
    RB[i] = *(const u32x4*)(Bt + (size_t)(lr + 32 * i) * ldb + (K0) + kc * 8);         \
  }
#define WA(RA, BUF, I) *(u32x4*)(smem + (BUF) * 18432 + wofs + (I) * 2304) = RA[I];
#define WB(RB, BUF, I) *(u32x4*)(smem + (BUF) * 18432 + 9216 + wofs + (I) * 2304) = RB[I];
#define FRAGS(BUF, KS, A0, A1, B0, B1)                                                 \
  A0 = *(const bf16x8*)(smem + (BUF) * 18432 + aofs + (KS) * 16);                      \
  A1 = *(const bf16x8*)(smem + (BUF) * 18432 + aofs + 32 * 72 + (KS) * 16);            \
  B0 = *(const bf16x8*)(smem + (BUF) * 18432 + bofs + (KS) * 16);                      \
  B1 = *(const bf16x8*)(smem + (BUF) * 18432 + bofs + 32 * 72 + (KS) * 16);
#define MMA4(A0, A1, B0, B1)                                                           \
  acc[0][0] = mfma(A0, B0, acc[0][0]);                                                 \
  acc[0][1] = mfma(A0, B1, acc[0][1]);                                                 \
  acc[1][0] = mfma(A1, B0, acc[1][0]);                                                 \
  acc[1][1] = mfma(A1, B1, acc[1][1]);
#define STEP(CB, WBUF, RA, RB, EN)                                                     \
  {                                                                                    \
    bf16x8 a0, a1, b0, b1, c0, c1, d0, d1;                                             \
    FRAGS(CB, 0, a0, a1, b0, b1)                                                       \
    FRAGS(CB, 1, c0, c1, d0, d1)                                                       \
    MMA4(a0, a1, b0, b1)                                                               \
    __builtin_amdgcn_sched_barrier(0);                                                 \
    FRAGS(CB, 2, a0, a1, b0, b1)                                                       \
    if (EN) { WA(RA, WBUF, 0) WB(RB, WBUF, 0) }                                        \
    MMA4(c0, c1, d0, d1)                                                               \
    __builtin_amdgcn_sched_barrier(0);                                                 \
    FRAGS(CB, 3, c0, c1, d0, d1)                                                       \
    if (EN) { WA(RA, WBUF, 1) WB(RB, WBUF, 1) WA(RA, WBUF, 2) }                        \
    MMA4(a0, a1, b0, b1)                                                               \
    __builtin_amdgcn_sched_barrier(0);                                                 \
    if (EN) { WB(RB, WBUF, 2) WA(RA, WBUF, 3) WB(RB, WBUF, 3) }                        \
    MMA4(c0, c1, d0, d1)                                                               \
    __builtin_amdgcn_sched_barrier(0);                                                 \
  }
  GLOAD(ra0, rb0, 0)
  GLOAD(ra1, rb1, 64)
#pragma unroll
  for (int a = 0; a < 2; ++a)
#pragma unroll
    for (int b = 0; b < 2; ++b)
#pragma unroll
      for (int i = 0; i < 16; ++i) acc[a][b][i] = 0.f;
  const int nk = K >> 6;
#pragma unroll
  for (int i = 0; i < 4; ++i) { WA(ra0, 0, i) WB(rb0, 0, i) }
  __syncthreads();
  for (int kt = 0; kt < nk; kt += 2) {
    if (kt + 2 < nk) { GLOAD(ra0, rb0, (kt + 2) << 6) }
    STEP(0, 1, ra1, rb1, true)
    __syncthreads();
    if (kt + 3 < nk) { GLOAD(ra1, rb1, (kt + 3) << 6) }
    STEP(1, 0, ra0, rb0, (kt + 2 < nk))
    __syncthreads();
  }
#undef GLOAD
#undef WA
#undef WB
#undef FRAGS
#undef MMA4
#undef STEP
}

#define LANE_VARS                                                   \
  const int tid = opaque_tid(), lane = tid & 63, w = tid >> 6;       \
  const int r = lane & 31, h = lane >> 5, wm = w >> 1, wn = w & 1;  \
  (void)tid; (void)lane; (void)w; (void)r; (void)h; (void)wm; (void)wn;
#define ACC_ROW(tm, i) (wm * 64 + (tm) * 32 + ((i) & 3) + 8 * ((i) >> 2) + 4 * h)

DEV void transpose_tile(const float* __restrict__ src, int lds_, int N, bf16_t* __restrict__ dst, int ldd,
                        int kt, int nt, int mode, float* sm) {
  const int tid = opaque_tid();
  __syncthreads();
  {
    float4 v[8];
#pragma unroll
    for (int i = 0; i < 8; ++i) {
      const int id = tid + i * 256;
      const int kk = id >> 5, n = nt * 128 + (id & 31) * 4;
      v[i] = make_float4(0.f, 0.f, 0.f, 0.f);
      if (n < N) v[i] = *(const float4*)(src + (size_t)(kt * 64 + kk) * lds_ + n);
    }
#pragma unroll
    for (int i = 0; i < 8; ++i) {
      const int id = tid + i * 256;
      float* d = sm + (id >> 5) * 129 + (id & 31) * 4;
      d[0] = v[i].x; d[1] = v[i].y; d[2] = v[i].z; d[3] = v[i].w;
    }
  }
  __syncthreads();
#pragma unroll
  for (int i = 0; i < 4; ++i) {
    const int id = tid + i * 256;
    const int nn = id >> 3, c = id & 7;
    const int n = nt * 128 + nn;
    int np = n;
    if (mode == 1) np = (n >> 7) * 256 + (n & 127);
    else if (mode == 2) np = (n >> 7) * 256 + 128 + (n & 127);
    u32x4 o;
    o.x = pack2(sm[(c * 8 + 0) * 129 + nn], sm[(c * 8 + 1) * 129 + nn]);
    o.y = pack2(sm[(c * 8 + 2) * 129 + nn], sm[(c * 8 + 3) * 129 + nn]);
    o.z = pack2(sm[(c * 8 + 4) * 129 + nn], sm[(c * 8 + 5) * 129 + nn]);
    o.w = pack2(sm[(c * 8 + 6) * 129 + nn], sm[(c * 8 + 7) * 129 + nn]);
    *(u32x4*)(dst + (size_t)np * ldd + kt * 64 + c * 8) = o;
  }
}

DEV void tr_load(const float* __restrict__ src, int lds_, int N, int kt, int nt, float4 (&v)[8]) {
  const int tid = opaque_tid();
#pragma unroll
  for (int i = 0; i < 8; ++i) {
    const int id = tid + i * 256;
    const int kk = id >> 5, n = nt * 128 + (id & 31) * 4;
    v[i] = make_float4(0.f, 0.f, 0.f, 0.f);
    if (n < N) {
      const f32x4nt* q_ = (const f32x4nt*)(src + (size_t)(kt * 64 + kk) * lds_ + n);
      const f32x4nt t_ = __builtin_nontemporal_load(q_);
      v[i] = make_float4(t_.x, t_.y, t_.z, t_.w);
    }
  }
}
DEV void tr_store(const float4 (&v)[8], bf16_t* __restrict__ dst, int ldd, int kt, int nt, int mode, float* sm) {
  const int tid = opaque_tid();
  __syncthreads();
#pragma unroll
  for (int i = 0; i < 8; ++i) {
    const int id = tid + i * 256;
    float* d = sm + (id >> 5) * 129 + (id & 31) * 4;
    d[0] = v[i].x; d[1] = v[i].y; d[2] = v[i].z; d[3] = v[i].w;
  }
  __syncthreads();
#pragma unroll
  for (int i = 0; i < 4; ++i) {
    const int id = tid + i * 256;
    const int nn = id >> 3, c = id & 7;
    const int n = nt * 128 + nn;
    int np = n;
    if (mode == 1) np = (n >> 7) * 256 + (n & 127);
    else if (mode == 2) np = (n >> 7) * 256 + 128 + (n & 127);
    u32x4 o;
    o.x = pack2(sm[(c * 8 + 0) * 129 + nn], sm[(c * 8 + 1) * 129 + nn]);
    o.y = pack2(sm[(c * 8 + 2) * 129 + nn], sm[(c * 8 + 3) * 129 + nn]);
    o.z = pack2(sm[(c * 8 + 4) * 129 + nn], sm[(c * 8 + 5) * 129 + nn]);
    o.w = pack2(sm[(c * 8 + 6) * 129 + nn], sm[(c * 8 + 7) * 129 + nn]);
    *(u32x4*)(dst + (size_t)np * ldd + kt * 64 + c * 8) = o;
  }
}

struct TrDesc { const float* src; bf16_t* dst; int K, N, Npad, ldd, mode; };
DEV TrDesc get_tr(const Params& p, int idx) {
  TrDesc d;
  char* ws = p.ws;
  if (idx < 12) {
    const int l = idx / 3, k = idx % 3;
    if (k == 0) { d.src = p.in[I_WGATE] + (size_t)l * 1024 * 2816; d.dst = (bf16_t*)(ws + WS_WGU) + (size_t)l * 5632 * 1024; d.K = 1024; d.N = 2816; d.Npad = 2816; d.ldd = 1024; d.mode = 1; }
    else if (k == 1) { d.src = p.in[I_WUP] + (size_t)l * 1024 * 2816; d.dst = (bf16_t*)(ws + WS_WGU) + (size_t)l * 5632 * 1024; d.K = 1024; d.N = 2816; d.Npad = 2816; d.ldd = 1024; d.mode = 2; }
    else { d.src = p.in[I_WDOWN] + (size_t)l * 2816 * 1024; d.dst = (bf16_t*)(ws + WS_WD) + (size_t)l * 1024 * 2816; d.K = 2816; d.N = 1024; d.Npad = 1024; d.ldd = 2816; d.mode = 0; }
  } else if (idx < 18) {
    const int e = (idx - 12) / 3, k = (idx - 12) % 3;
    if (k == 0) { d.src = p.in[I_WINE] + (size_t)e * 1024 * 2048; d.dst = (bf16_t*)(ws + WS_WINE) + (size_t)e * 2048 * 1024; d.K = 1024; d.N = 2048; d.Npad = 2048; d.ldd = 1024; d.mode = 0; }
    else if (k == 1) { d.src = p.in[I_WOUTE] + (size_t)e * 1024 * 1024; d.dst = (bf16_t*)(ws + WS_WOUTE) + (size_t)e * 1024 * 1024; d.K = 1024; d.N = 1024; d.Npad = 1024; d.ldd = 1024; d.mode = 0; }
    else { d.src = p.in[I_GLUW] + (size_t)e * 512 * 512; d.dst = (bf16_t*)(ws + WS_GLU) + (size_t)e * 512 * 512; d.K = 512; d.N = 512; d.Npad = 512; d.ldd = 512; d.mode = 0; }
  } else {
    const int o = (idx - 18) / 4, k = (idx - 18) % 4;
    if (k == 0) { d.src = p.in[I_WINO] + (size_t)o * 1024 * 416; d.dst = (bf16_t*)(ws + WS_WINO) + (size_t)o * 512 * 1024; d.K = 1024; d.N = 416; d.Npad = 512; d.ldd = 1024; d.mode = 0; }
    else if (k == 1) { d.src = p.in[I_WQUP] + (size_t)o * 256 * 1536; d.dst = (bf16_t*)(ws + WS_WQ) + (size_t)o * 1536 * 256; d.K = 256; d.N = 1536; d.Npad = 1536; d.ldd = 256; d.mode = 0; }
    else if (k == 2) { d.src = p.in[I_WKVUP] + (size_t)o * 128 * 2048; d.dst = (bf16_t*)(ws + WS_WKV) + (size_t)o * 2048 * 128; d.K = 128; d.N = 2048; d.Npad = 2048; d.ldd = 128; d.mode = 0; }
    else { d.src = p.in[I_WOUTO] + (size_t)o * 1024 * 1024; d.dst = (bf16_t*)(ws + WS_WOUTO) + (size_t)o * 1024 * 1024; d.K = 1024; d.N = 1024; d.Npad = 1024; d.ldd = 1024; d.mode = 0; }
  }
  return d;
}

DEV void mod_task(const Params& p, int task, float* sm) {
  const int tid = opaque_tid();
  const int l = task / 96, n0 = (task % 96) * 64;
  float* sc = sm;
  float* red = sm + 9 * 1024;
  __syncthreads();
  for (int i = tid; i < 9 * 1024; i += 256) {
    const int ci = i >> 10, k = i & 1023;
    const float v = (ci < 8) ? p.in[I_C][ci * 1024 + k] : p.in[I_CCTX][k];
    sc[i] = siluf(v);
  }
  __syncthreads();
  const int col = tid & 63, kq = tid >> 6;
  const float* W = p.in[I_WMOD] + (size_t)l * 1024 * 6144 + n0 + col;
  float a[9];
#pragma unroll
  for (int j = 0; j < 9; ++j) a[j] = 0.f;
  for (int k = kq * 256; k < kq * 256 + 256; k += 16) {
    float wv[16];
#pragma unroll
    for (int u = 0; u < 16; ++u) wv[u] = __builtin_nontemporal_load(W + (size_t)(k + u) * 6144);
#pragma unroll
    for (int u = 0; u < 16; u += 4)
#pragma unroll
      for (int j = 0; j < 9; ++j) {
        const float4 sv = *(const float4*)(sc + j * 1024 + k + u);
        a[j] += sv.x * wv[u] + sv.y * wv[u + 1] + sv.z * wv[u + 2] + sv.w * wv[u + 3];
      }
  }
#pragma unroll
  for (int j = 0; j < 9; ++j) red[(kq * 9 + j) * 64 + col] = a[j];
  __syncthreads();
  for (int i = tid; i < 9 * 64; i += 256) {
    const int j = i >> 6, c = i & 63;
    const float v = red[(0 * 9 + j) * 64 + c] + red[(1 * 9 + j) * 64 + c] + red[(2 * 9 + j) * 64 + c] + red[(3 * 9 + j) * 64 + c];
    float mv = v + p.in[I_BMOD][l * 6144 + n0 + c];
    const int sec = (n0 + c) >> 10, cc = (n0 + c) & 1023;
    if (sec == 1) mv = p.in[I_GPREMIX][l * 1024 + cc] * (1.f + mv);
    else if (sec == 2) mv = p.in[I_GPOSTMIX][l * 1024 + cc] * mv;
    else if (sec == 4) mv = p.in[I_GPREFFN][l * 1024 + cc] * (1.f + mv);
    else if (sec == 5) mv = p.in[I_GPOSTFFN][l * 1024 + cc] * mv;
    ((float*)(p.ws + WS_MOD))[(size_t)(l * 9 + j) * 6144 + n0 + c] = mv;
  }
}

DEV void s5_build_task(const Params& p, int task4, float* sm) {
  const int tid = opaque_tid();
  const int task = task4 >> 2, sub = task4 & 3;
  const int e = task >> 5, g = task & 31;
  float* apow = sm;
  float* bbs = apow + 2 * 17 * 64 * 2;
  float* cs = bbs + 2 * 64 * 16 * 2;
  float* fs = cs + 2 * 16 * 64 * 2;
  __syncthreads();
  if (tid < 128) {
    const int d = tid >> 6, pp = tid & 63;
    const int gi = (e * 2 + d) * 32 + g;
    const float lr = p.in[I_LAMRE][gi * 64 + pp], li = p.in[I_LAMIM][gi * 64 + pp];
    const float dt = expf(p.in[I_LOGDT][gi]);
    for (int tau = 0; tau <= 16; ++tau) {
      const float mag = expf((float)tau * lr * dt);
      double th = (double)tau * (double)li * (double)dt;
      th -= 6.283185307179586476925 * rint(th * 0.15915494309189533577);
      float sn, cn;
      sincosf((float)th, &sn, &cn);
      apow[((d * 17 + tau) * 64 + pp) * 2 + 0] = mag * cn;
      apow[((d * 17 + tau) * 64 + pp) * 2 + 1] = mag * sn;
      if (tau == 16 && sub == 0) {
        float* at = (float*)(p.ws + WS_AT) + ((size_t)gi * 64 + pp) * 2;
        at[0] = mag * cn; at[1] = mag * sn;
      }
      if (tau == 1) {
        const float are = mag * cn, aim = mag * sn;
        const float den = lr * lr + li * li;
        fs[(d * 64 + pp) * 2 + 0] = ((are - 1.f) * lr + aim * li) / den;
        fs[(d * 64 + pp) * 2 + 1] = (aim * lr - (are - 1.f) * li) / den;
      }
    }
  }
  __syncthreads();
  for (int i = tid; i < 2048; i += 256) {
    const int d = i >> 10, pp = (i >> 4) & 63, hi = i & 15;
    const size_t gi = (size_t)((e * 2 + d) * 32 + g);
    const float br = p.in[I_BRE][(gi * 64 + pp) * 16 + hi], bi = p.in[I_BIM][(gi * 64 + pp) * 16 + hi];
    const float fr = fs[(d * 64 + pp) * 2], fi = fs[(d * 64 + pp) * 2 + 1];
    bbs[i * 2 + 0] = fr * br - fi * bi;
    bbs[i * 2 + 1] = fr * bi + fi * br;
    const int ho = (i >> 6) & 15, p2 = i & 63;
    cs[i * 2 + 0] = p.in[I_CRE][(gi * 16 + ho) * 64 + p2];
    cs[i * 2 + 1] = p.in[I_CIM][(gi * 16 + ho) * 64 + p2];
  }
  __syncthreads();
  bf16_t* Gt = (bf16_t*)(p.ws + WS_GT) + (size_t)(e * 32 + g) * 65536;
  bf16_t* TEt = (bf16_t*)(p.ws + WS_TET) + (size_t)(e * 32 + g) * 131072;
  {
    const int s = tid >> 4, hi = tid & 15;
    for (int n = sub * 64; n < sub * 64 + 64; ++n) {
      const int d = n >> 7, ri = (n >> 6) & 1, pp = n & 63;
      const int pw = d == 0 ? 15 - s : s;
      const float ar = apow[((d * 17 + pw) * 64 + pp) * 2], ai = apow[((d * 17 + pw) * 64 + pp) * 2 + 1];
      const float br = bbs[((d * 64 + pp) * 16 + hi) * 2], bi = bbs[((d * 64 + pp) * 16 + hi) * 2 + 1];
      const float v = ri == 0 ? (ar * br - ai * bi) : (ar * bi + ai * br);
      Gt[n * 256 + tid] = f2bf(v);
    }
  }
  {
    const int d = tid >> 7, ri = (tid >> 6) & 1, pp = tid & 63;
    for (int n = sub * 64; n < sub * 64 + 64; ++n) {
      const int t = n >> 4, ho = n & 15;
      const int pw = d == 0 ? t + 1 : 16 - t;
      const float ar = apow[((d * 17 + pw) * 64 + pp) * 2], ai = apow[((d * 17 + pw) * 64 + pp) * 2 + 1];
      const float cr = cs[((d * 16 + ho) * 64 + pp) * 2], ci = cs[((d * 16 + ho) * 64 + pp) * 2 + 1];
      const float v = ri == 0 ? (cr * ar - ci * ai) : -(cr * ai + ci * ar);
      TEt[n * 512 + 256 + tid] = f2bf(v);
    }
  }
  {
    const int ho = tid >> 4, hi = tid & 15;
    for (int j = sub * 8; j < sub * 8 + 8; ++j) {
      const int d = j >> 4, tau = j & 15;
      if (d == 1 && tau == 0) continue;
      float v = 0.f;
      for (int pp = 0; pp < 64; ++pp) {
        const float cr = cs[((d * 16 + ho) * 64 + pp) * 2], ci = cs[((d * 16 + ho) * 64 + pp) * 2 + 1];
        const float ar = apow[((d * 17 + tau) * 64 + pp) * 2], ai = apow[((d * 17 + tau) * 64 + pp) * 2 + 1];
        const float br = bbs[((d * 64 + pp) * 16 + hi) * 2], bi = bbs[((d * 64 + pp) * 16 + hi) * 2 + 1];
        const float xr = cr * ar - ci * ai, xi = cr * ai + ci * ar;
        v += xr * br - xi * bi;
      }
      if (tau == 0) {
        for (int pp = 0; pp < 64; ++pp) {
          const float cr = cs[((16 + ho) * 64 + pp) * 2], ci = cs[((16 + ho) * 64 + pp) * 2 + 1];
          const float br = bbs[((64 + pp) * 16 + hi) * 2], bi = bbs[((64 + pp) * 16 + hi) * 2 + 1];
          v += cr * br - ci * bi;
        }
        if (ho == hi) v += p.in[I_S5D][e * 512 + g * 16 + ho];
        const bf16_t bv = f2bf(v);
        for (int t = 0; t < 16; ++t) TEt[(t * 16 + ho) * 512 + t * 16 + hi] = bv;
      } else if (d == 0) {
        const bf16_t bv = f2bf(v);
        for (int t = tau; t < 16; ++t) TEt[(t * 16 + ho) * 512 + (t - tau) * 16 + hi] = bv;
      } else {
        const bf16_t bv = f2bf(v);
        for (int t = 0; t < 16 - tau; ++t) TEt[(t * 16 + ho) * 512 + (t + tau) * 16 + hi] = bv;
      }
    }
  }
}

DEV void tr_run(const Params& p, unsigned dsel, int vb, int nvb, float* smf) {
  int total = 0;
  for (int di = 0; di < 26; ++di) if ((dsel >> di) & 1u) { const TrDesc d = get_tr(p, di); total += (d.K >> 6) * (d.Npad >> 7); }
  float4 vc[8], vn[8];
  TrDesc dc = get_tr(p, 0), dn = dc;
  int tc = 0, tn = 0;
  auto decode = [&](int gi, TrDesc& d, int& t) {
    int rem = gi;
    for (int di = 0; di < 26; ++di) {
      if (!((dsel >> di) & 1u)) continue;
      d = get_tr(p, di);
      const int cnt = (d.K >> 6) * (d.Npad >> 7);
      if (rem < cnt) break;
      rem -= cnt;
    }
    t = rem;
  };
  int gi = vb;
  if (gi < total) { decode(gi, dc, tc); const int ntn = dc.Npad >> 7; tr_load(dc.src, dc.N, dc.N, tc / ntn, tc % ntn, vc); }
  for (; gi < total; gi += nvb) {
    const int gn = gi + nvb;
    if (gn < total) { decode(gn, dn, tn); const int ntn = dn.Npad >> 7; tr_load(dn.src, dn.N, dn.N, tn / ntn, tn % ntn, vn); }
    { const int ntn = dc.Npad >> 7; tr_store(vc, dc.dst, dc.ldd, tc / ntn, tc % ntn, dc.mode, smf); }
#pragma unroll
    for (int i = 0; i < 8; ++i) vc[i] = vn[i];
    dc = dn; tc = tn;
  }
}
DEV unsigned tr_layer_mask(int l) {
  unsigned m = 7u << (3 * l);
  if ((l & 1) == 0) m |= 7u << (12 + 3 * (l >> 1));
  else m |= 15u << (18 + 4 * (l >> 1));
  return m;
}

DEV void phase0(const Params& p, float* smf) {
  const int tid = opaque_tid(), nb = VNB, bid = VBID;
  for (int t = bid; t < 256; t += nb) s5_build_task(p, t, smf);
  for (int t = (bid + nb - 256 % nb) % nb; t < 96; t += nb) mod_task(p, t, smf);
  {
    float* rd = (float*)(p.ws + WS_ROPED);
    float* rm = (float*)(p.ws + WS_ROPEM);
    for (int i = bid * 256 + tid; i < 1024 * 32 + 1024 * 16; i += nb * 256) {
      if (i < 1024 * 32) {
        const int pos = i >> 5, j = i & 31;
        const float base = (j < 16) ? (float)(pos >> 6) : (float)(pos & 63);
        const float inv = exp2f(-(float)(j & 15) * (13.287712379549449f / 16.f));
        float sn, cn;
        sincosf(base * inv, &sn, &cn);
        rd[i] = cn; rd[1024 * 32 + i] = sn;
      } else {
        const int ii = i - 1024 * 32;
        const int pos = ii >> 4, j = ii & 15;
        const float base = (j < 8) ? (float)(pos >> 6) : (float)(pos & 63);
        const float inv = exp2f(-(float)(j & 7) * (13.287712379549449f / 8.f));
        float sn, cn;
        sincosf(base * inv, &sn, &cn);
        rm[ii] = cn; rm[1024 * 16 + ii] = sn;
      }
    }
    if (bid == nb - 1 && tid < 2) {
      const int e = tid;
      float s1 = 0.f, s2 = 0.f;
      for (int i = 0; i < 64; ++i) {
        s1 += p.in[I_LQ1][e * 64 + i] * p.in[I_LK1][e * 64 + i];
        s2 += p.in[I_LQ2][e * 64 + i] * p.in[I_LK2][e * 64 + i];
      }
      const float lam_init = 0.8f - 0.6f * expf(-0.3f * (float)(2 * e));
      float* lv = (float*)(p.ws + WS_LAM);
      lv[e * 2 + 0] = expf(s1) - expf(s2) + lam_init;
      lv[e * 2 + 1] = lam_init;
    }
  }
  if (bid >= 352) tr_run(p, tr_layer_mask(0), bid - 352, nb - 352, smf);
}

DEV void row_phase(const Params& p, int mode, int l) {
  const int tid_ = opaque_tid();
  const int lane = tid_ & 63;
  const int gw = VBID * 4 + (tid_ >> 6), nw = VNB * 4;
  const float* mod = (const float*)(p.ws + WS_MOD);
  const bf16_t* Y = (const bf16_t*)(p.ws + WS_Y);
  const bf16_t* Y2 = (const bf16_t*)(p.ws + WS_Y2);
  bf16_t* H = (bf16_t*)(p.ws + WS_H);
  bf16_t* XB = (bf16_t*)(p.ws + WS_XB);
#define ROW_LOAD(M, X, YB, Y2B)                                                                         \
  {                                                                                                     \
    if (mode == 0 || (mode == 1 && l == 0)) {                                                           \
      const float* src_ = ((M) < NCTX ? p.in[I_XP] + (size_t)(M) * 1024 : p.in[I_XS] + (size_t)((M) - NCTX) * 1024); \
      _Pragma("unroll") for (int i = 0; i < 4; ++i) X[i] = *(const float4*)(src_ + i * 256 + lane * 4); \
    } else {                                                                                            \
      _Pragma("unroll") for (int i = 0; i < 4; ++i) {                                                   \
        const u32x2 xb_ = *(const u32x2*)(XB + (size_t)(M) * 1024 + i * 256 + lane * 4);                \
        X[i].x = __uint_as_float(xb_.x << 16); X[i].y = __uint_as_float(xb_.x & 0xffff0000u);           \
        X[i].z = __uint_as_float(xb_.y << 16); X[i].w = __uint_as_float(xb_.y & 0xffff0000u);           \
      }                                                                                                 \
    }                                                                                                   \
    if (mode != 0) {                                                                                    \
      _Pragma("unroll") for (int i = 0; i < 4; ++i)                                                     \
        YB[i] = *(const u32x2*)(Y + (size_t)(M) * 1024 + i * 256 + lane * 4);                           \
    }                                                                                                   \
  }
  float4 xc[4], xn[4];
  u32x2 yc[4], y2c[4], yn[4], y2n[4];
#pragma unroll
  for (int i = 0; i < 4; ++i) { yc[i] = mk2(0, 0); y2c[i] = mk2(0, 0); yn[i] = mk2(0, 0); y2n[i] = mk2(0, 0); xn[i] = make_float4(0.f, 0.f, 0.f, 0.f); }
  if (gw < NTOK) ROW_LOAD(gw, xc, yc, y2c)
  const bool last = (mode == 2 && l == 3);
  for (int m = gw; m < NTOK; m += nw) {
    const int mnext = m + nw;
    if (mnext < NTOK) ROW_LOAD(mnext, xn, yn, y2n)
    const int ci = m < NCTX ? 8 : ((m - NCTX) >> 10);
    const float* mr = mod + (size_t)(l * 9 + ci) * 6144;
    if (mode != 0) {
      const float* a1p = mr + (mode == 1 ? 2 : 5) * 1024;
      float4 a1[4];
#pragma unroll
      for (int i = 0; i < 4; ++i) a1[i] = *(const float4*)(a1p + i * 256 + lane * 4);
      float4 y[4];
      float ss = 0.f;
#pragma unroll
      for (int i = 0; i < 4; ++i) {
        y[i].x = __uint_as_float(yc[i].x << 16); y[i].y = __uint_as_float(yc[i].x & 0xffff0000u);
        y[i].z = __uint_as_float(yc[i].y << 16); y[i].w = __uint_as_float(yc[i].y & 0xffff0000u);
        if (false) {
          y[i].x += __uint_as_float(y2c[i].x << 16); y[i].y += __uint_as_float(y2c[i].x & 0xffff0000u);
          y[i].z += __uint_as_float(y2c[i].y << 16); y[i].w += __uint_as_float(y2c[i].y & 0xffff0000u);
        }
        ss += y[i].x * y[i].x + y[i].y * y[i].y + y[i].z * y[i].z + y[i].w * y[i].w;
      }
      ss = wave_sum(ss);
      const float rs = rsqrtf(ss * (1.f / 1024.f) + EPS);
#pragma unroll
      for (int i = 0; i < 4; ++i) {
        xc[i].x += a1[i].x * (y[i].x * rs);
        xc[i].y += a1[i].y * (y[i].y * rs);
        xc[i].z += a1[i].z * (y[i].z * rs);
        xc[i].w += a1[i].w * (y[i].w * rs);
      }
    }
    const float *a2p, *a3p;
    if (mode == 1) { a2p = mr + 4 * 1024; a3p = mr + 3 * 1024; }
    else {
      const int l2 = (mode == 0) ? 0 : (l + 1) & 3;
      const float* mr2 = mod + (size_t)(l2 * 9 + ci) * 6144;
      a2p = mr2 + 1024; a3p = mr2;
    }
    float4 a2[4], a3[4];
    if (!last) {
#pragma unroll
      for (int i = 0; i < 4; ++i) {
        a2[i] = *(const float4*)(a2p + i * 256 + lane * 4);
        a3[i] = *(const float4*)(a3p + i * 256 + lane * 4);
      }
    }
    if (last) {
#pragma unroll
      for (int i = 0; i < 4; ++i) { f32x4nt t_; t_.x = xc[i].x; t_.y = xc[i].y; t_.z = xc[i].z; t_.w = xc[i].w; __builtin_nontemporal_store(t_, (f32x4nt*)(p.out + (size_t)m * 1024 + i * 256 + lane * 4)); }
    } else if (mode != 0) {
#pragma unroll
      for (int i = 0; i < 4; ++i) {
        u32x2 o; o.x = pack2(xc[i].x, xc[i].y); o.y = pack2(xc[i].z, xc[i].w);
        *(u32x2*)(XB + (size_t)m * 1024 + i * 256 + lane * 4) = o;
      }
    }
    if (!last) {
      float ss2 = 0.f;
#pragma unroll
      for (int i = 0; i < 4; ++i) ss2 += xc[i].x * xc[i].x + xc[i].y * xc[i].y + xc[i].z * xc[i].z + xc[i].w * xc[i].w;
      ss2 = wave_sum(ss2);
      const float rs2 = rsqrtf(ss2 * (1.f / 1024.f) + EPS);
#pragma unroll
      for (int i = 0; i < 4; ++i) {
        u32x2 o;
        o.x = pack2(xc[i].x * rs2 * a2[i].x + a3[i].x, xc[i].y * rs2 * a2[i].y + a3[i].y);
        o.y = pack2(xc[i].z * rs2 * a2[i].z + a3[i].z, xc[i].w * rs2 * a2[i].w + a3[i].w);
        *(u32x2*)(H + (size_t)m * 1024 + i * 256 + lane * 4) = o;
      }
    }
#pragma unroll
    for (int i = 0; i < 4; ++i) { xc[i] = xn[i]; yc[i] = yn[i]; y2c[i] = y2n[i]; }
  }
#undef ROW_LOAD
}


DEV void even_cache_tasks(const Params& p, int e, float* smf, int bid, int nb) {
  const int tid = opaque_tid();
  bf16_t* KD = (bf16_t*)(p.ws + WS_KD);
  for (int i = bid * 256 + tid; i < 8 * 512 * 64; i += nb * 256) {
    const int row = i >> 6, c = i & 63;
    const int b = row >> 9, j = row & 511;
    const float* s = p.in[I_CDK] + ((size_t)(b * 2 + e) * 512 + j) * 512 + c * 8;
    const f32x4nt v0 = __builtin_nontemporal_load((const f32x4nt*)s), v1 = __builtin_nontemporal_load((const f32x4nt*)(s + 4));
    u32x4 o; o.x = pack2(v0.x, v0.y); o.y = pack2(v0.z, v0.w); o.z = pack2(v1.x, v1.y); o.w = pack2(v1.z, v1.w);
    *(u32x4*)(KD + (size_t)(NCTX + b * 1536 + j) * 512 + c * 8) = o;
  }
  bf16_t* VL = (bf16_t*)(p.ws + WS_VTDL);
  for (int t = bid; t < 8 * 4 * 8; t += nb) {
    const int bh = t >> 3, kt = t & 7, nt = 0;
    const int b = bh >> 2, hh = bh & 3;
    const float* src = p.in[I_CDV] + (size_t)(b * 2 + e) * 512 * 512 + hh * 128;
    transpose_tile(src, 512, 128, VL + (size_t)(b * 4 + hh) * 128 * 1536, 1536, kt, nt, 0, smf);
  }
}

template <int DQK, int DV, int NKT, class KF>
DEV void flash_block(const bf16_t* __restrict__ qrow  , KF kptr,
                     const bf16_t* __restrict__ Vt, int ldv, int nkeys, float scale_log2, bf16_t* smem,
                     f32x16 (&O)[DV / 32], float& l_out) {
  int tid = threadIdx.x; asm volatile("" : "+v"(tid));
  const int lane = tid & 63, w = tid >> 6;
  const int r = lane & 31, h = lane >> 5;
  constexpr int KSTR = DQK + 8, VSTR = 68;
  constexpr int NKC = DQK / 8;
  constexpr int KTOT = NKT * 64 * NKC;
  constexpr int KCH = (KTOT + 511) / 512;
  constexpr int VCH = DV * 8 / 512;
  const bf16_t* sK = smem;
  const bf16_t* sV = smem + NKT * 64 * KSTR;
  const int cw = (NKT == 2) ? (w >> 2) : 0;
  bf16x8 qf[DQK / 16];
#pragma unroll
  for (int s = 0; s < DQK / 16; ++s) qf[s] = *(const bf16x8*)(qrow + s * 16 + h * 8);
  u32x4 rk[KCH], rv[VCH];
#pragma unroll
  for (int i = 0; i < KCH; ++i) rk[i] = mk4(0, 0, 0, 0);
  constexpr int BUFE = NKT * 64 * KSTR + DV * VSTR;
#define FL_LOAD(KEY0)                                                                   \
  {                                                                                     \
    _Pragma("unroll") for (int i = 0; i < KCH; ++i) {                                   \
      const int id = tid + i * 512;                                                     \
      const int c = id % NKC, row = (id / NKC) & 63, comp = id / (NKC * 64);            \
      if (id < KTOT) rk[i] = *(const u32x4*)kptr(comp, (KEY0) + row, c);                \
    }                                                                                   \
    _Pragma("unroll") for (int i = 0; i < VCH; ++i) {                                   \
      const int id = tid + i * 512;                                                     \
      rv[i] = *(const u32x4*)(Vt + (size_t)(id >> 3) * ldv + (KEY0) + (id & 7) * 8);    \
    }                                                                                   \
  }
#define FL_WRITE(BUF)                                                                   \
  {                                                                                     \
    bf16_t* sKw = smem + (BUF) * BUFE;                                                  \
    bf16_t* sVw = sKw + NKT * 64 * KSTR;                                                \
    _Pragma("unroll") for (int i = 0; i < KCH; ++i) {                                   \
      const int id = tid + i * 512;                                                     \
      const int c = id % NKC, row = (id / NKC) & 63, comp = id / (NKC * 64);            \
      if (id < KTOT) *(u32x4*)(sKw + (comp * 64 + row) * KSTR + c * 8) = rk[i];         \
    }                                                                                   \
    _Pragma("unroll") for (int i = 0; i < VCH; ++i) {                                   \
      const int id = tid + i * 512;                                                     \
      bf16_t* d = sVw + (id >> 3) * VSTR + (id & 7) * 8;                                \
      *(u32x2*)d = mk2(rv[i].x, rv[i].y);                                               \
      *(u32x2*)(d + 4) = mk2(rv[i].z, rv[i].w);                                         \
    }                                                                                   \
  }
  float m_run = -INFINITY, l_run = 0.f;
#pragma unroll
  for (int v = 0; v < DV / 32; ++v)
#pragma unroll
    for (int i = 0; i < 16; ++i) O[v][i] = 0.f;
  const int ntile = nkeys >> 6;
  FL_LOAD(0)
  FL_WRITE(0)
  if (ntile > 1) FL_LOAD(64)
  __syncthreads();
  for (int kt = 0; kt < ntile; ++kt) {
    if (kt + 1 < ntile) FL_WRITE((kt + 1) & 1)
    if (kt + 2 < ntile) FL_LOAD((kt + 2) << 6)
    sK = smem + (kt & 1) * BUFE;
    sV = sK + NKT * 64 * KSTR;
    f32x16 st[2];
#pragma unroll
    for (int kh = 0; kh < 2; ++kh)
#pragma unroll
      for (int i = 0; i < 16; ++i) st[kh][i] = 0.f;
#pragma unroll
    for (int s = 0; s < DQK / 16; ++s)
#pragma unroll
      for (int kh = 0; kh < 2; ++kh) {
        const bf16x8 kf = *(const bf16x8*)(sK + (cw * 64 + kh * 32 + r) * KSTR + s * 16 + h * 8);
        st[kh] = mfma(kf, qf[s], st[kh]);
      }
    float mx;
    {
      float m0 = fmaxf(fmaxf(st[0][0], st[0][1]), st[0][2]), m1 = fmaxf(fmaxf(st[1][0], st[1][1]), st[1][2]);
#pragma unroll
      for (int i = 3; i < 15; i += 2) { m0 = fmaxf(fmaxf(m0, st[0][i]), st[0][i + 1]); m1 = fmaxf(fmaxf(m1, st[1][i]), st[1][i + 1]); }
      mx = fmaxf(fmaxf(m0, m1), fmaxf(st[0][15], st[1][15]));
    }
    mx = fmaxf(mx, __shfl_xor(mx, 32));
    const float m_new = fmaxf(m_run, mx * scale_log2);
    const float alpha = fast_exp2(m_run - m_new);
    typedef float f32x2_t __attribute__((ext_vector_type(2)));
    f32x2_t ps2 = {0.f, 0.f};
    const f32x2_t sc2 = {scale_log2, scale_log2}, mn2 = {-m_new, -m_new};
#pragma unroll
    for (int kh = 0; kh < 2; ++kh)
#pragma unroll
      for (int i = 0; i < 16; i += 2) {
        f32x2_t v = {st[kh][i], st[kh][i + 1]};
        v = __builtin_elementwise_fma(v, sc2, mn2);
        f32x2_t e;
        e.x = fast_exp2(v.x); e.y = fast_exp2(v.y);
        ps2 += e;
        st[kh][i] = e.x; st[kh][i + 1] = e.y;
      }
    const float ps = ps2.x + ps2.y;
    l_run = l_run * alpha + ps;
    m_run = m_new;
    if (__builtin_amdgcn_ballot_w64(alpha != 1.f) != 0ull) {
#pragma unroll
      for (int v = 0; v < DV / 32; ++v)
#pragma unroll
        for (int i = 0; i < 16; ++i) O[v][i] *= alpha;
    }
#pragma unroll
    for (int kh = 0; kh < 2; ++kh)
#pragma unroll
      for (int s2 = 0; s2 < 2; ++s2) {
        union { u32x4 u; bf16x8 v; } pb;
        pb.u.x = pack2(st[kh][8 * s2 + 0], st[kh][8 * s2 + 1]);
        pb.u.y = pack2(st[kh][8 * s2 + 2], st[kh][8 * s2 + 3]);
        pb.u.z = pack2(st[kh][8 * s2 + 4], st[kh][8 * s2 + 5]);
        pb.u.w = pack2(st[kh][8 * s2 + 6], st[kh][8 * s2 + 7]);
#pragma unroll
        for (int v = 0; v < DV / 32; ++v) {
          const bf16_t* vp = sV + (v * 32 + r) * VSTR + kh * 32 + s2 * 16 + 4 * h;
          union { u32x4 u; bf16x8 v; } vf;
          const u32x2 lo = *(const u32x2*)vp, hi = *(const u32x2*)(vp + 8);
          vf.u = mk4(lo.x, lo.y, hi.x, hi.y);
          O[v] = mfma(vf.v, pb.v, O[v]);
        }
      }
    __syncthreads();
  }
  l_out = l_run + __shfl_xor(l_run, 32);
#undef FL_LOAD
#undef FL_WRITE
}

DEV void diff_attn_task(const Params& p, int e, int task, bf16_t* smem) {
  int t512 = threadIdx.x; asm volatile("" : "+v"(t512));
  const int lane = t512 & 63, w = t512 >> 6, r = lane & 31, h = lane >> 5;
  int b, hh, qb, mq0, keyrow0, nkeys, ldv;
  const bf16_t* Vt;
  if (task < 256) {
    b = task >> 5; hh = (task >> 3) & 3; qb = task & 7;
    mq0 = NCTX + b * 1024 + qb * 128; keyrow0 = NCTX + b * 1536; nkeys = 1536; ldv = 1536;
    Vt = (const bf16_t*)(p.ws + WS_VTDL) + (size_t)(b * 4 + hh) * 128 * 1536;
  } else {
    const int t2 = task - 256;
    b = t2 >> 3; hh = (t2 >> 1) & 3; qb = t2 & 1;
    mq0 = b * 256 + qb * 128; keyrow0 = b * 256; nkeys = 256; ldv = 256;
    Vt = (const bf16_t*)(p.ws + WS_VTDC) + (size_t)(b * 4 + hh) * 128 * 256;
  }
  const int cw = w >> 2, qw = (w & 3) * 32;
  const bf16_t* QD = (const bf16_t*)(p.ws + WS_QD);
  const bf16_t* KD = (const bf16_t*)(p.ws + WS_KD) + (size_t)keyrow0 * 512 + hh * 128;
  const int mq = mq0 + qw + r;
  f32x16 O[4];
  float l;
  flash_block<64, 128, 2>(QD + (size_t)mq * 512 + hh * 128 + cw * 64,
                          [&](int comp, int key, int c) { return KD + (size_t)key * 512 + comp * 64 + c * 8; },
                          Vt, ldv, nkeys, 0.125f * 1.4426950408889634f, smem, O, l);
  const float inv = 1.f / l;
  float* sO = (float*)smem;
  if (w >= 4) {
#pragma unroll
    for (int v = 0; v < 4; ++v)
#pragma unroll
      for (int i = 0; i < 16; ++i) {
        const int vd = v * 32 + (i & 3) + 8 * (i >> 2) + 4 * h;
        sO[((w - 4) * 128 + vd) * 32 + r] = O[v][i] * inv;
      }
  }
  __syncthreads();
  if (w < 4) {
    const float* lv = (const float*)(p.ws + WS_LAM);
    const float lam = lv[e * 2], lam_init = lv[e * 2 + 1];
    float ss = 0.f;
#pragma unroll
    for (int v = 0; v < 4; ++v)
#pragma unroll
      for (int i = 0; i < 16; ++i) {
        const int vd = v * 32 + (i & 3) + 8 * (i >> 2) + 4 * h;
        const float o = O[v][i] * inv - lam * sO[(w * 128 + vd) * 32 + r];
        O[v][i] = o;
        ss += o * o;
      }
    ss += __shfl_xor(ss, 32);
    const float rs = rsqrtf(ss * (1.f / 128.f) + EPS) * (1.f - lam_init);
    const float* sg = p.in[I_SUBLN] + e * 128;
    bf16_t* Yc = (bf16_t*)(p.ws + WS_YCAT) + (size_t)mq * 1024 + 512 + hh * 128;
#pragma unroll
    for (int v = 0; v < 4; ++v)
#pragma unroll
      for (int g4 = 0; g4 < 4; ++g4) {
        const int vd = v * 32 + 8 * g4 + 4 * h;
        const float4 gg = *(const float4*)(sg + vd);
        u32x2 o;
        o.x = pack2(O[v][g4 * 4 + 0] * rs * gg.x, O[v][g4 * 4 + 1] * rs * gg.y);
        o.y = pack2(O[v][g4 * 4 + 2] * rs * gg.z, O[v][g4 * 4 + 3] * rs * gg.w);
        *(u32x2*)(Yc + vd) = o;
      }
  }
  __syncthreads();
}

DEV void mla_attn_task(const Params& p, int task, bf16_t* smem) {
  int t512 = threadIdx.x; asm volatile("" : "+v"(t512));
  const int lane = t512 & 63, w = t512 >> 6, r = lane & 31, h = lane >> 5;
  int b, hd, qb, mq0, keyrow0, nkeys, ldv;
  const bf16_t* Vt;
  if (task < 512) {
    b = task >> 6; hd = (task >> 2) & 15; qb = task & 3;
    mq0 = NCTX + b * 1024 + qb * 256; keyrow0 = NCTX + b * 1536; nkeys = 1536; ldv = 1536;
    Vt = (const bf16_t*)(p.ws + WS_VTML) + (size_t)(b * 16 + hd) * 64 * 1536;
  } else {
    const int t2 = task - 512;
    b = t2 >> 4; hd = t2 & 15; qb = 0;
    mq0 = b * 256; keyrow0 = b * 256; nkeys = 256; ldv = 256;
    Vt = (const bf16_t*)(p.ws + WS_VTMC) + (size_t)(b * 16 + hd) * 64 * 256;
  }
  (void)qb;
  const bf16_t* QM = (const bf16_t*)(p.ws + WS_QM);
  const bf16_t* KN = (const bf16_t*)(p.ws + WS_KN) + (size_t)keyrow0 * 1024 + hd * 64;
  const bf16_t* KR = (const bf16_t*)(p.ws + WS_KRA) + (size_t)keyrow0 * 32;
  const int mq = mq0 + w * 32 + r;
  f32x16 O[2];
  float l;
  flash_block<96, 64, 1>(QM + (size_t)mq * 1536 + hd * 96,
                         [&](int comp, int key, int c) { return c < 8 ? KN + (size_t)key * 1024 + c * 8 : KR + (size_t)key * 32 + (c - 8) * 8; },
                         Vt, ldv, nkeys, 0.10206207261596575f * 1.4426950408889634f, smem, O, l);
  const float inv = 1.f / l;
  bf16_t* Yc = (bf16_t*)(p.ws + WS_YCAT) + (size_t)mq * 1024 + hd * 64;
#pragma unroll
  for (int v = 0; v < 2; ++v)
#pragma unroll
    for (int g4 = 0; g4 < 4; ++g4) {
      const int vd = v * 32 + 8 * g4 + 4 * h;
      u32x2 o;
      o.x = pack2(O[v][g4 * 4 + 0] * inv, O[v][g4 * 4 + 1] * inv);
      o.y = pack2(O[v][g4 * 4 + 2] * inv, O[v][g4 * 4 + 3] * inv);
      *(u32x2*)(Yc + vd) = o;
    }
}

DEV void s5_sgemm_tile(const Params& p, int e, int t, bf16_t* smem) {
  LANE_VARS
  const int g = t / 12, mt = (t % 12) >> 1, nt = t & 1;
  const int m0 = mt * 128, n0 = nt * 128;
  const bf16_t* Ug = (const bf16_t*)(p.ws + WS_UG) + (size_t)g * NTOK * 16;
  const bf16_t* Bt = (const bf16_t*)(p.ws + WS_GT) + (size_t)(e * 32 + g) * 65536 + (size_t)n0 * 256;
  f32x16 acc[2][2];
  gemm_mainloop([&](int row, int k) { return Ug + (size_t)(m0 + row) * 256 + k; }, Bt, 256, 256, smem, acc);
  float* S = (float*)(p.ws + WS_S) + (size_t)g * 768 * 256;
#pragma unroll
  for (int tm = 0; tm < 2; ++tm)
#pragma unroll
    for (int tn = 0; tn < 2; ++tn)
#pragma unroll
      for (int i = 0; i < 16; ++i)
        S[(size_t)(m0 + ACC_ROW(tm, i)) * 256 + n0 + wn * 64 + tn * 32 + r] = acc[tm][tn][i];
}

DEV void s5_scan_phase(const Params& p, int e) {
  const float* S = (const float*)(p.ws + WS_S);
  bf16_t* Hin = (bf16_t*)(p.ws + WS_HIN);
  for (int it = VBID * 256 + opaque_tid(); it < 24 * 4096; it += VNB * 256) {
    const int pp = it & 63, d = (it >> 6) & 1, g = (it >> 7) & 31, seq = it >> 12;
    int base, nc;
    float hr = 0.f, hi = 0.f;
    if (seq < 16) { base = seq * 16; nc = 16; }
    else {
      const int b = seq - 16; base = 256 + b * 64; nc = 64;
      const size_t si = ((size_t)((b * 2 + e) * 2 + d)) * 2048 + g * 64 + pp;
      hr = p.in[I_S5RE][si]; hi = p.in[I_S5IM][si];
    }
    const float* at = (const float*)(p.ws + WS_AT) + ((size_t)((e * 2 + d) * 32 + g) * 64 + pp) * 2;
    const float ar = at[0], ai = at[1];
    const size_t col = (size_t)d * 128 + pp;
    const float* Sg = S + (size_t)g * 768 * 256;
    bf16_t* Hg = Hin + (size_t)g * 768 * 256;
#pragma unroll 4
    for (int c = 0; c < nc; ++c) {
      const int row = base + (d == 0 ? c : nc - 1 - c);
      const float sr = Sg[(size_t)row * 256 + col], si = Sg[(size_t)row * 256 + col + 64];
      Hg[(size_t)row * 256 + col] = f2bf(hr);
      Hg[(size_t)row * 256 + col + 64] = f2bf(hi);
      const float nr = ar * hr - ai * hi + sr, ni = ar * hi + ai * hr + si;
      hr = nr; hi = ni;
    }
    if (seq < 16) {
      const size_t oi = ((size_t)((seq * 2 + e) * 2 + d)) * 2048 + g * 64 + pp;
      p.out[O_S5RE + oi] = hr;
      p.out[O_S5IM + oi] = hi;
    }
  }
}

DEV void s5_ygemm_tile(const Params& p, int e, int t, bf16_t* smem) {
  LANE_VARS
  const int g = t / 12, mt = (t % 12) >> 1, nt = t & 1;
  const int m0 = mt * 128, n0 = nt * 128;
  const bf16_t* Ug = (const bf16_t*)(p.ws + WS_UG) + (size_t)g * NTOK * 16;
  const bf16_t* Hg = (const bf16_t*)(p.ws + WS_HIN) + (size_t)g * 768 * 256;
  const bf16_t* Bt = (const bf16_t*)(p.ws + WS_TET) + (size_t)(e * 32 + g) * 131072 + (size_t)n0 * 512;
  f32x16 acc[2][2];
  gemm_mainloop([&](int row, int k) { return k < 256 ? Ug + (size_t)(m0 + row) * 256 + k : Hg + (size_t)(m0 + row) * 256 + (k - 256); },
                Bt, 512, 512, smem, acc);
  bf16_t* G = (bf16_t*)(p.ws + WS_G);
#pragma unroll
  for (int tm = 0; tm < 2; ++tm)
#pragma unroll
    for (int tn = 0; tn < 2; ++tn)
#pragma unroll
      for (int i = 0; i < 16; ++i) {
        const int m = m0 + ACC_ROW(tm, i), n = n0 + wn * 64 + tn * 32 + r;
        const int tok = m * 16 + (n >> 4);
        G[(size_t)tok * 512 + g * 16 + (n & 15)] = f2bf(gelu_tanh(acc[tm][tn][i]));
      }
}

DEV void glu_tile(const Params& p, int e, int t, bf16_t* smem) {
  LANE_VARS
  const int mt = t >> 2, nt = t & 3;
  const int m0 = mt * 128, n0 = nt * 128;
  const bf16_t* G = (const bf16_t*)(p.ws + WS_G);
  const bf16_t* Bt = (const bf16_t*)(p.ws + WS_GLU) + (size_t)e * 512 * 512 + (size_t)n0 * 512;
  f32x16 acc[2][2];
  gemm_mainloop([&](int row, int k) { return G + (size_t)(m0 + row) * 512 + k; }, Bt, 512, 512, smem, acc);
  bf16_t* Yc = (bf16_t*)(p.ws + WS_YCAT);
  const float* gb = p.in[I_GLUB] + e * 512;
#pragma unroll
  for (int tm = 0; tm < 2; ++tm)
#pragma unroll
    for (int tn = 0; tn < 2; ++tn) {
      const int n = n0 + wn * 64 + tn * 32 + r;
      const float bias = gb[n];
#pragma unroll
      for (int i = 0; i < 16; ++i) {
        const int m = m0 + ACC_ROW(tm, i);
        const float gv = bf2f(G[(size_t)m * 512 + n]);
        Yc[(size_t)m * 1024 + n] = f2bf(gv * sigmoidf(acc[tm][tn][i] + bias));
      }
    }
}


DEV void odd_inproj_tile(const Params& p, int o, int t, bf16_t* smem) {
  LANE_VARS
  const int mt = t >> 2, nt = t & 3;
  const int m0 = mt * 128, n0 = nt * 128;
  const bf16_t* H = (const bf16_t*)(p.ws + WS_H);
  const bf16_t* Bt = (const bf16_t*)(p.ws + WS_WINO) + (size_t)o * 512 * 1024 + (size_t)n0 * 1024;
  f32x16 acc[2][2];
  gemm_mainloop([&](int row, int k) { return H + (size_t)(m0 + row) * 1024 + k; }, Bt, 1024, 1024, smem, acc);
  float* PR = (float*)(p.ws + WS_PROJO);
#pragma unroll
  for (int tm = 0; tm < 2; ++tm)
#pragma unroll
    for (int tn = 0; tn < 2; ++tn)
#pragma unroll
      for (int i = 0; i < 16; ++i) {
        const int m = m0 + ACC_ROW(tm, i), n = n0 + wn * 64 + tn * 32 + r;
        if (n < 416) PR[(size_t)m * 416 + n] = acc[tm][tn][i];
      }
}

DEV void odd_cache_rows(const Params& p, int o, int vb, int nvb) {
  bf16_t* CKVA = (bf16_t*)(p.ws + WS_CKVA);
  bf16_t* KRA = (bf16_t*)(p.ws + WS_KRA);
  for (int i = vb * 256 + opaque_tid(); i < 8 * 512 * 16; i += nvb * 256) {
    const int row = i >> 4, c = i & 15;
    const int b = row >> 9, j = row & 511;
    const float* s = p.in[I_CCKV] + ((size_t)(b * 2 + o) * 512 + j) * 128 + c * 8;
    const f32x4nt v0 = __builtin_nontemporal_load((const f32x4nt*)s), v1 = __builtin_nontemporal_load((const f32x4nt*)(s + 4));
    u32x4 ov; ov.x = pack2(v0.x, v0.y); ov.y = pack2(v0.z, v0.w); ov.z = pack2(v1.x, v1.y); ov.w = pack2(v1.z, v1.w);
    *(u32x4*)(CKVA + (size_t)(NCTX + b * 1536 + j) * 128 + c * 8) = ov;
    if (c < 4) {
      const float* s2 = p.in[I_CKR] + ((size_t)(b * 2 + o) * 512 + j) * 32 + c * 8;
      const f32x4nt w0 = __builtin_nontemporal_load((const f32x4nt*)s2), w1 = __builtin_nontemporal_load((const f32x4nt*)(s2 + 4));
      u32x4 ok; ok.x = pack2(w0.x, w0.y); ok.y = pack2(w0.z, w0.w); ok.z = pack2(w1.x, w1.y); ok.w = pack2(w1.z, w1.w);
      *(u32x4*)(KRA + (size_t)(NCTX + b * 1536 + j) * 32 + c * 8) = ok;
    }
  }
}
DEV void odd_row_phase(const Params& p, int o) {
  const int tid_ = opaque_tid();
  const int lane = tid_ & 63;
  const int gw = VBID * 4 + (tid_ >> 6), nw = VNB * 4;
  const float* PR = (const float*)(p.ws + WS_PROJO);
  bf16_t* CQ = (bf16_t*)(p.ws + WS_CQ);
  bf16_t* CKVA = (bf16_t*)(p.ws + WS_CKVA);
  bf16_t* KRA = (bf16_t*)(p.ws + WS_KRA);
  const float* rc = (const float*)(p.ws + WS_ROPEM);
  const float* rsn = rc + 1024 * 16;
  const float4 gq = *(const float4*)(p.in[I_QNORM] + o * 256 + lane * 4);
  const float2 gk = *(const float2*)(p.in[I_KVNORM] + o * 128 + lane * 2);
  float4 q4 = make_float4(0.f, 0.f, 0.f, 0.f), q4n = q4;
  float2 k2 = make_float2(0.f, 0.f), k2n = k2;
  float krv = 0.f, krvn = 0.f;
  if (gw < NTOK) {
    const float* row = PR + (size_t)gw * 416;
    q4 = *(const float4*)(row + lane * 4);
    k2 = *(const float2*)(row + 256 + lane * 2);
    if (lane < 32) krv = row[384 + lane];
  }
  for (int m = gw; m < NTOK; m += nw) {
    if (m + nw < NTOK) {
      const float* rown = PR + (size_t)(m + nw) * 416;
      q4n = *(const float4*)(rown + lane * 4);
      k2n = *(const float2*)(rown + 256 + lane * 2);
      if (lane < 32) krvn = rown[384 + lane];
    }
    float ss = q4.x * q4.x + q4.y * q4.y + q4.z * q4.z + q4.w * q4.w;
    ss = wave_sum(ss);
    const float rq = rsqrtf(ss * (1.f / 256.f) + EPS);
    u32x2 oq;
    oq.x = pack2(q4.x * rq * gq.x, q4.y * rq * gq.y);
    oq.y = pack2(q4.z * rq * gq.z, q4.w * rq * gq.w);
    *(u32x2*)(CQ + (size_t)m * 256 + lane * 4) = oq;
    float sk = k2.x * k2.x + k2.y * k2.y;
    sk = wave_sum(sk);
    const float rk = rsqrtf(sk * (1.f / 128.f) + EPS);
    const float c0 = k2.x * rk * gk.x, c1 = k2.y * rk * gk.y;
    const bool lat = m >= NCTX;
    const int pos = (m - NCTX) & 1023;
    const size_t keyrow = lat ? (size_t)(NCTX + ((m - NCTX) >> 10) * 1536 + 512 + pos) : (size_t)m;
    *(uint32_t*)(CKVA + keyrow * 128 + lane * 2) = pack2(c0, c1);
    const float partner = __shfl_xor(krv, 16);
    if (!lat) {
      const int b = m >> 8, j = m & 255;
      *(float2*)(p.out + O_CKV + ((size_t)(b * 2 + o) * 256 + j) * 128 + lane * 2) = make_float2(c0, c1);
      if (lane < 32) {
        p.out[O_KR + ((size_t)(b * 2 + o) * 256 + j) * 32 + lane] = krv;
        KRA[keyrow * 32 + lane] = f2bf(krv);
      }
    } else if (lane < 32) {
      const float c = rc[pos * 16 + (lane & 15)], s = rsn[pos * 16 + (lane & 15)];
      const float v = (lane & 16) ? (krv * c + partner * s) : (krv * c - partner * s);
      KRA[keyrow * 32 + lane] = f2bf(v);
    }
    q4 = q4n; k2 = k2n; krv = krvn;
  }
}

DEV void qup_tile(const Params& p, int o, int t, bf16_t* smem) {
  LANE_VARS
  const int mt = t / 12, nt = t % 12;
  const int m0 = mt * 128, n0 = nt * 128;
  const bf16_t* CQ = (const bf16_t*)(p.ws + WS_CQ);
  const bf16_t* Bt = (const bf16_t*)(p.ws + WS_WQ) + (size_t)o * 1536 * 256 + (size_t)n0 * 256;
  f32x16 acc[2][2];
  gemm_mainloop([&](int row, int k) { return CQ + (size_t)(m0 + row) * 256 + k; }, Bt, 256, 256, smem, acc);
  bf16_t* QM = (bf16_t*)(p.ws + WS_QM);
  const float* rc = (const float*)(p.ws + WS_ROPEM);
  const float* rsn = rc + 1024 * 16;
  const bool lat = m0 >= NCTX;
#pragma unroll
  for (int tn = 0; tn < 2; ++tn) {
    const int nb32 = (n0 >> 5) + wn * 2 + tn;
    const bool rope = lat && (nb32 % 3 == 2);
    const int n = nb32 * 32 + r;
#pragma unroll
    for (int tm = 0; tm < 2; ++tm)
#pragma unroll
      for (int i = 0; i < 16; ++i) {
        const int m = m0 + ACC_ROW(tm, i);
        float v = acc[tm][tn][i];
        if (rope) {
          const float partner = __shfl_xor(v, 16);
          const int pos = (m - NCTX) & 1023;
          const float c = rc[pos * 16 + (r & 15)], s = rsn[pos * 16 + (r & 15)];
          v = (r & 16) ? (v * c + partner * s) : (v * c - partner * s);
        }
        QM[(size_t)m * 1536 + n] = f2bf(v);
      }
  }
}

DEV void kvup_task(const Params& p, int o, int task, bf16_t* smem) {
  LANE_VARS
  const int mt = task >> 2, hq = task & 3;
  const int m0 = mt * 128;
  const bf16_t* CK = (const bf16_t*)(p.ws + WS_CKVA) + (size_t)m0 * 128;
  const bf16_t* W = (const bf16_t*)(p.ws + WS_WKV) + (size_t)o * 2048 * 128;
  bf16_t* sA = smem;
  bf16_t* sB = smem + 2 * 9216;
  const int kc = tid & 7, lr = tid >> 3;
  u32x4 rb[8];
  {
    u32x4 ra[8];
#pragma unroll
    for (int kt = 0; kt < 2; ++kt)
#pragma unroll
      for (int i = 0; i < 4; ++i) {
        ra[kt * 4 + i] = *(const u32x4*)(CK + (size_t)(lr + 32 * i) * 128 + kt * 64 + kc * 8);
        rb[kt * 4 + i] = *(const u32x4*)(W + (size_t)((hq * 4) * 128 + lr + 32 * i) * 128 + kt * 64 + kc * 8);
      }
#pragma unroll
    for (int kt = 0; kt < 2; ++kt)
#pragma unroll
      for (int i = 0; i < 4; ++i) {
        *(u32x4*)(sA + kt * 9216 + (lr + 32 * i) * 72 + kc * 8) = ra[kt * 4 + i];
        *(u32x4*)(sB + kt * 9216 + (lr + 32 * i) * 72 + kc * 8) = rb[kt * 4 + i];
      }
  }
  __syncthreads();
  const bool lat = m0 >= NCTX;
  for (int j = 0; j < 4; ++j) {
    const int hd = hq * 4 + j;
    if (j + 1 < 4) {
#pragma unroll
      for (int kt = 0; kt < 2; ++kt)
#pragma unroll
        for (int i = 0; i < 4; ++i)
          rb[kt * 4 + i] = *(const u32x4*)(W + (size_t)((hd + 1) * 128 + lr + 32 * i) * 128 + kt * 64 + kc * 8);
    }
    f32x16 acc[2][2];
#pragma unroll
    for (int a = 0; a < 2; ++a)
#pragma unroll
      for (int b = 0; b < 2; ++b)
#pragma unroll
        for (int i = 0; i < 16; ++i) acc[a][b][i] = 0.f;
#pragma unroll
    for (int kt = 0; kt < 2; ++kt)
#pragma unroll
      for (int ks = 0; ks < 4; ++ks) {
        const bf16x8 a0 = *(const bf16x8*)(sA + kt * 9216 + (wm * 64 + r) * 72 + ks * 16 + h * 8);
        const bf16x8 a1 = *(const bf16x8*)(sA + kt * 9216 + (wm * 64 + 32 + r) * 72 + ks * 16 + h * 8);
        const bf16x8 b0 = *(const bf16x8*)(sB + kt * 9216 + (wn * 64 + r) * 72 + ks * 16 + h * 8);
        const bf16x8 b1 = *(const bf16x8*)(sB + kt * 9216 + (wn * 64 + 32 + r) * 72 + ks * 16 + h * 8);
        acc[0][0] = mfma(a0, b0, acc[0][0]);
        acc[0][1] = mfma(a0, b1, acc[0][1]);
        acc[1][0] = mfma(a1, b0, acc[1][0]);
        acc[1][1] = mfma(a1, b1, acc[1][1]);
      }
    if (wn == 0) {
      bf16_t* KN = (bf16_t*)(p.ws + WS_KN);
#pragma unroll
      for (int tm = 0; tm < 2; ++tm)
#pragma unroll
        for (int tn = 0; tn < 2; ++tn)
#pragma unroll
          for (int i = 0; i < 16; ++i)
            KN[(size_t)(m0 + ACC_ROW(tm, i)) * 1024 + hd * 64 + tn * 32 + r] = f2bf(acc[tm][tn][i]);
    } else {
#pragma unroll
      for (int tm = 0; tm < 2; ++tm)
#pragma unroll
        for (int tn = 0; tn < 2; ++tn) {
          const int vd = tn * 32 + r;
#pragma unroll
          for (int g4 = 0; g4 < 4; ++g4) {
            const int m4 = m0 + wm * 64 + tm * 32 + 8 * g4 + 4 * h;
            u32x2 ov;
            ov.x = pack2(acc[tm][tn][g4 * 4 + 0], acc[tm][tn][g4 * 4 + 1]);
            ov.y = pack2(acc[tm][tn][g4 * 4 + 2], acc[tm][tn][g4 * 4 + 3]);
            bf16_t* dst;
            if (!lat) { const int b = m4 >> 8, jj = m4 & 255; dst = (bf16_t*)(p.ws + WS_VTMC) + ((size_t)(b * 16 + hd) * 64 + vd) * 256 + jj; }
            else { const int mm = m4 - NCTX; const int b = mm / 1536, jj = mm % 1536; dst = (bf16_t*)(p.ws + WS_VTML) + ((size_t)(b * 16 + hd) * 64 + vd) * 1536 + jj; }
            *(u32x2*)dst = ov;
          }
        }
    }
    __syncthreads();
    if (j + 1 < 4) {
#pragma unroll
      for (int kt = 0; kt < 2; ++kt)
#pragma unroll
        for (int i = 0; i < 4; ++i) *(u32x4*)(sB + kt * 9216 + (lr + 32 * i) * 72 + kc * 8) = rb[kt * 4 + i];
    }
    __syncthreads();
  }
}

namespace pg8 {
#define PG8_LAS __attribute__((address_space(3)))
typedef short sbf16x8 __attribute__((ext_vector_type(8)));
typedef float f32x4 __attribute__((ext_vector_type(4)));
constexpr int BM = 256, BK = 64, HALF = 128, HTB = HALF * BK * 2, STAGE_BYTES = 8 * HTB, NXCD = 8, WGM = 8;
DEV int lds_byte(int r, int c) { const int st = (r >> 4) * 2 + (c >> 5), rr = r & 15, cc = c & 31, ob = rr * 64 + cc * 2; return st * 1024 + (ob ^ (((ob >> 9) & 1) << 5)); }
DEV void stage_rc(int b, int& R, int& C) { const int st = b / 1024, sb = b % 1024, swz = sb ^ (((sb >> 9) & 1) << 5); R = (st >> 1) * 16 + swz / 64; C = (st & 1) * 32 + (swz % 64) / 2; }
DEV int perm32(int rho) { const int n = rho >> 4, i = rho & 15; return 8 * (i >> 2) + 4 * n + (i & 3); }
DEV int perm_rope(int R) { return 64 * (R >> 6) + 32 * ((R >> 4) & 1) + 16 * ((R >> 5) & 1) + (R & 15); }
struct Unit { int pm, pn; };
struct Gemm { const bf16_t* A; const bf16_t* Bt; int M, N, K; };
struct StaticOrder {
  int nM, nN, nwg, G, c;
  DEV void init(int M, int N, int G_, int c_) { nM = M / BM; nN = N / BM; nwg = nM * nN; G = G_; c = c_; }
  DEV bool next(int i, Unit& u) const {
    const long L = (long)i * G + c; if (L >= nwg) return false;
    int wgid = (int)L; { const int q = nwg / NXCD, r = nwg % NXCD, xcd = wgid % NXCD, off = wgid / NXCD; wgid = (xcd < r ? xcd * (q + 1) : r * (q + 1) + (xcd - r) * q) + off; }
    const int nig = WGM * nN, gid = wgid / nig, fm = gid * WGM, gsz = (nM - fm) < WGM ? (nM - fm) : WGM;
    u.pm = fm + ((wgid % nig) % gsz); u.pn = (wgid % nig) / gsz; return true;
  }
};
struct EpiGateUp {
  static constexpr int PERMID = 1;
  bf16_t* ACT;
  DEV void operator()(const f32x4 (&acc)[2][2][4][2], const Unit& u, int wr, int wc, int fr, int fq) const {
    const int row0 = u.pm * BM + wr * 64 + fr, col0 = u.pn * 128 + wc * 32 + 8 * fq;
#pragma unroll
    for (int ai = 0; ai < 2; ++ai)
#pragma unroll
      for (int m = 0; m < 4; ++m) {
        const f32x4 g0 = acc[ai][0][m][0], g1 = acc[ai][0][m][1], v0 = acc[ai][1][m][0], v1 = acc[ai][1][m][1];
        u32x4 w;
        w.x = pack2(siluf(g0[0]) * v0[0], siluf(g0[1]) * v0[1]);
        w.y = pack2(siluf(g0[2]) * v0[2], siluf(g0[3]) * v0[3]);
        w.z = pack2(siluf(g1[0]) * v1[0], siluf(g1[1]) * v1[1]);
        w.w = pack2(siluf(g1[2]) * v1[2], siluf(g1[3]) * v1[3]);
        *(u32x4*)(ACT + (size_t)(row0 + ai * HALF + m * 16) * 2816 + col0) = w;
      }
  }
};
struct EpiY {
  static constexpr int PERMID = 1;
  bf16_t* O;
  DEV void operator()(const f32x4 (&acc)[2][2][4][2], const Unit& u, int wr, int wc, int fr, int fq) const {
    const int row0 = u.pm * BM + wr * 64 + fr, col0 = u.pn * BM + wc * 32 + 8 * fq;
#pragma unroll
    for (int ai = 0; ai < 2; ++ai)
#pragma unroll
      for (int m = 0; m < 4; ++m) {
        bf16_t* rowp = O + (size_t)(row0 + ai * HALF + m * 16) * 1024 + col0;
#pragma unroll
        for (int bj = 0; bj < 2; ++bj) {
          const f32x4 v0 = acc[ai][bj][m][0], v1 = acc[ai][bj][m][1];
          u32x4 w; w.x = pack2(v0[0], v0[1]); w.y = pack2(v0[2], v0[3]); w.z = pack2(v1[0], v1[1]); w.w = pack2(v1[2], v1[3]);
          *(u32x4*)(rowp + bj * HALF) = w;
        }
      }
  }
};
struct EpiInEven {
  static constexpr int PERMID = 2;
  bf16_t *Ug, *QD, *KD; float* out_dk; const float* rc; int e;
  DEV void operator()(const f32x4 (&acc)[2][2][4][2], const Unit& u, int wr, int wc, int fr, int fq) const {
    const int region = u.pn >> 1;
    const bool lat = u.pm >= (NCTX / 256);
    const float* rsn = rc + 1024 * 32;
#pragma unroll
    for (int ai = 0; ai < 2; ++ai)
#pragma unroll
      for (int m = 0; m < 4; ++m) {
        const int row = u.pm * BM + ai * HALF + wr * 64 + m * 16 + fr;
        const int pos = (row - NCTX) & 1023;
#pragma unroll
        for (int bj = 0; bj < 2; ++bj) {
          const int cb = (u.pn & 1) * 256 + bj * 128 + 64 * (wc >> 1) + 16 * (wc & 1) + 4 * fq;
          const f32x4 a0 = acc[ai][bj][m][0], a1 = acc[ai][bj][m][1];
          if (region == 0) {
            u32x2 w0, w1;
            w0.x = pack2(a0[0], a0[1]); w0.y = pack2(a0[2], a0[3]);
            w1.x = pack2(a1[0], a1[1]); w1.y = pack2(a1[2], a1[3]);
            *(u32x2*)(Ug + ((size_t)(cb >> 4) * NTOK + row) * 16 + (cb & 15)) = w0;
            *(u32x2*)(Ug + ((size_t)((cb + 32) >> 4) * NTOK + row) * 16 + (cb & 15)) = w1;
          } else {
            f32x4 o0 = a0, o1 = a1;
            if (lat) {
              const int d0 = cb & 63;
              const f32x4 c4 = *(const f32x4*)(rc + pos * 32 + d0), s4 = *(const f32x4*)(rsn + pos * 32 + d0);
              o0 = a0 * c4 - a1 * s4; o1 = a1 * c4 + a0 * s4;
            }
            u32x2 w0, w1;
            w0.x = pack2(o0[0], o0[1]); w0.y = pack2(o0[2], o0[3]);
            w1.x = pack2(o1[0], o1[1]); w1.y = pack2(o1[2], o1[3]);
            if (region == 1) {
              *(u32x2*)(QD + (size_t)row * 512 + cb) = w0;
              *(u32x2*)(QD + (size_t)row * 512 + cb + 32) = w1;
            } else {
              const size_t keyrow = lat ? (size_t)(NCTX + ((row - NCTX) >> 10) * 1536 + 512 + pos) : (size_t)row;
              *(u32x2*)(KD + keyrow * 512 + cb) = w0;
              *(u32x2*)(KD + keyrow * 512 + cb + 32) = w1;
              if (!lat) {
                float* o = out_dk + ((size_t)((row >> 8) * 2 + e) * 256 + (row & 255)) * 512 + cb;
                __builtin_nontemporal_store(a0, (f32x4*)o); __builtin_nontemporal_store(a1, (f32x4*)(o + 32));
              }
            }
          }
        }
      }
  }
};
struct EpiVt {
  static constexpr int PERMID = 1;
  bf16_t *VC, *VL; float* out_dv; int e;
  DEV void operator()(const f32x4 (&acc)[2][2][4][2], const Unit& u, int wr, int wc, int fr, int fq) const {
#pragma unroll
    for (int ai = 0; ai < 2; ++ai)
#pragma unroll
      for (int m = 0; m < 4; ++m) {
        const int vdt = u.pm * BM + ai * HALF + wr * 64 + m * 16 + fr;
        const int hh = vdt >> 7, vd = vdt & 127;
#pragma unroll
        for (int bj = 0; bj < 2; ++bj) {
          const int t0 = u.pn * BM + bj * HALF + wc * 32 + 8 * fq;
          const f32x4 v0 = acc[ai][bj][m][0], v1 = acc[ai][bj][m][1];
          u32x4 w; w.x = pack2(v0[0], v0[1]); w.y = pack2(v0[2], v0[3]); w.z = pack2(v1[0], v1[1]); w.w = pack2(v1[2], v1[3]);
          if (t0 < NCTX) {
            const int b = t0 >> 8, j0 = t0 & 255;
            *(u32x4*)(VC + ((size_t)(b * 4 + hh) * 128 + vd) * 256 + j0) = w;
            float* o = out_dv + ((size_t)(b * 2 + e) * 256 + j0) * 512 + vdt;
            __builtin_nontemporal_store(v0[0], o); __builtin_nontemporal_store(v0[1], o + 512); __builtin_nontemporal_store(v0[2], o + 1024); __builtin_nontemporal_store(v0[3], o + 1536);
            __builtin_nontemporal_store(v1[0], o + 2048); __builtin_nontemporal_store(v1[1], o + 2560); __builtin_nontemporal_store(v1[2], o + 3072); __builtin_nontemporal_store(v1[3], o + 3584);
          } else {
            const int mm = t0 - NCTX;
            const int b = mm >> 10, j0 = 512 + (mm & 1023);
            *(u32x4*)(VL + ((size_t)(b * 4 + hh) * 128 + vd) * 1536 + j0) = w;
          }
        }
      }
  }
};
template <class Epi>
DEV void gemm_phase(PG8_LAS unsigned char* lds, const Gemm g, const StaticOrder& S, const Epi& E) {
  int tid = threadIdx.x; asm volatile("" : "+v"(tid));
  const int wid = __builtin_amdgcn_readfirstlane(tid >> 6), lane = tid & 63, wr = wid >> 2, wc = wid & 3, fr = lane & 15, fq = lane >> 4;
  const int K = g.K, nt = K / BK;
  unsigned voffA[2], voffB[2];
#pragma unroll
  for (int i = 0; i < 2; ++i) { int R, C; stage_rc(tid * 16 + i * 8192, R, C); const int Rb = Epi::PERMID == 1 ? ((R & ~31) + perm32(R & 31)) : (Epi::PERMID == 2 ? perm_rope(R) : R);
    voffA[i] = (unsigned)(R * K + C) * 2u; voffB[i] = (unsigned)(Rb * K + C) * 2u; }
  const size_t kstep = (size_t)(BK * 2);
  const size_t hstep = (size_t)HALF * K * 2;
  const size_t tstep = 2 * hstep;
  const unsigned ldsw = (unsigned)wid * 1024u;
  const int aoff = lds_byte(wr * 64 + fr, fq * 8), boff = lds_byte(wc * 32 + fr, fq * 8);
#define PG8_SA(b, h) (((b) * 2 + (h)) * HTB)
#define PG8_SB(b, h) ((4 + (b) * 2 + (h)) * HTB)
#define PG8_STAGE(bufoff, gbase, voff) do { _Pragma("unroll") for (int _i = 0; _i < 2; ++_i) \
    __builtin_amdgcn_global_load_lds((const unsigned*)((const char*)(gbase) + (voff)[_i]), (PG8_LAS unsigned*)(lds + (bufoff) + ldsw + _i * 8192), 16, 0, 0); } while (0)
#define PG8_LDA(dst, b, h) do { _Pragma("unroll") for (int m = 0; m < 4; ++m) _Pragma("unroll") for (int k = 0; k < 2; ++k) dst[m][k] = *(const PG8_LAS sbf16x8*)(lds + PG8_SA(b, h) + aoff + m * 2048 + k * 1024); } while (0)
#define PG8_LDB(dst, b, h) do { _Pragma("unroll") for (int n = 0; n < 2; ++n) _Pragma("unroll") for (int k = 0; k < 2; ++k) dst[n][k] = *(const PG8_LAS sbf16x8*)(lds + PG8_SB(b, h) + boff + n * 2048 + k * 1024); } while (0)
#define PG8_MMA(ai, bj, At, Bt) do { __builtin_amdgcn_s_setprio(1); _Pragma("unroll") for (int m = 0; m < 4; ++m) _Pragma("unroll") for (int n = 0; n < 2; ++n) _Pragma("unroll") for (int k = 0; k < 2; ++k) \
    acc[ai][bj][m][n] = __builtin_amdgcn_mfma_f32_16x16x32_bf16(__builtin_bit_cast(bf16x8, Bt[n][k]), __builtin_bit_cast(bf16x8, At[m][k]), acc[ai][bj][m][n], 0, 0, 0); __builtin_amdgcn_s_setprio(0); } while (0)
#define PG8_WAIT_V(n) asm volatile("s_waitcnt vmcnt(" #n ")" ::: "memory")
#define PG8_WAIT_L(n) asm volatile("s_waitcnt lgkmcnt(" #n ")" ::: "memory")
#define PG8_BAR __builtin_amdgcn_s_barrier()
#define PG8_SCHED __builtin_amdgcn_sched_barrier(0)
  Unit cur, nxt; int ui = 0;
  if (!S.next(0, cur)) return;
  f32x4 acc[2][2][4][2];
#pragma unroll
  for (int a = 0; a < 2; ++a)
#pragma unroll
    for (int b = 0; b < 2; ++b)
#pragma unroll
      for (int m = 0; m < 4; ++m)
#pragma unroll
        for (int n = 0; n < 2; ++n) acc[a][b][m][n] = (f32x4){0.f, 0.f, 0.f, 0.f};
  sbf16x8 At[4][2], B0[2][2], B1[2][2];
  const char* cA = (const char*)g.A + (size_t)cur.pm * tstep; const char* cB = (const char*)g.Bt + (size_t)cur.pn * tstep;
  PG8_STAGE(PG8_SB(0, 0), cB, voffB); PG8_STAGE(PG8_SA(0, 0), cA, voffA); PG8_STAGE(PG8_SB(0, 1), cB + hstep, voffB); PG8_STAGE(PG8_SA(0, 1), cA + hstep, voffA);
  if (wr == 1) PG8_BAR;
  PG8_WAIT_V(4); PG8_BAR;
  PG8_STAGE(PG8_SB(1, 0), cB + kstep, voffB); PG8_STAGE(PG8_SA(1, 0), cA + kstep, voffA); PG8_STAGE(PG8_SB(1, 1), cB + hstep + kstep, voffB);
  PG8_WAIT_V(6); PG8_BAR;
  for (;;) {
    const bool has_next = S.next(ui + 1, nxt);
    const char* nA = has_next ? (const char*)g.A + (size_t)nxt.pm * tstep : cA; const char* nB = has_next ? (const char*)g.Bt + (size_t)nxt.pn * tstep : cB;
    for (int t = 0; t < nt; t += 2) {
      const bool last = (t == nt - 2);
      const char* a1 = cA + (size_t)(t + 1) * kstep;
      const char* a2 = last ? nA : cA + (size_t)(t + 2) * kstep; const char* b2 = last ? nB : cB + (size_t)(t + 2) * kstep;
      const char* a3 = a2 + kstep; const char* b3 = b2 + kstep;
      PG8_LDB(B0, 0, 0); PG8_SCHED; PG8_LDA(At, 0, 0); PG8_STAGE(PG8_SA(1, 1), a1 + hstep, voffA);
      PG8_WAIT_L(8); PG8_BAR; PG8_WAIT_L(0); PG8_MMA(0, 0, At, B0); PG8_BAR; PG8_SCHED;
      PG8_LDB(B1, 0, 1); PG8_STAGE(PG8_SB(0, 0), b2, voffB);
      PG8_BAR; PG8_WAIT_L(0); PG8_MMA(0, 1, At, B1); PG8_BAR;
      PG8_LDA(At, 0, 1); PG8_STAGE(PG8_SA(0, 0), a2, voffA);
      PG8_BAR; PG8_WAIT_L(0); PG8_MMA(1, 0, At, B0); PG8_BAR; PG8_SCHED;
      PG8_STAGE(PG8_SB(0, 1), b2 + hstep, voffB);
      PG8_WAIT_V(6); PG8_BAR; PG8_MMA(1, 1, At, B1); PG8_BAR;
      PG8_LDB(B0, 1, 0); PG8_SCHED; PG8_LDA(At, 1, 0); PG8_STAGE(PG8_SA(0, 1), a2 + hstep, voffA);
      PG8_WAIT_L(8); PG8_BAR; PG8_WAIT_L(0); PG8_MMA(0, 0, At, B0); PG8_BAR; PG8_SCHED;
      PG8_LDB(B1, 1, 1); PG8_STAGE(PG8_SB(1, 0), b3, voffB);
      PG8_BAR; PG8_WAIT_L(0); PG8_MMA(0, 1, At, B1); PG8_BAR;
      PG8_LDA(At, 1, 1); PG8_STAGE(PG8_SA(1, 0), a3, voffA);
      PG8_BAR; PG8_WAIT_L(0); PG8_MMA(1, 0, At, B0); PG8_BAR; PG8_SCHED;
      PG8_STAGE(PG8_SB(1, 1), b3 + hstep, voffB);
      PG8_WAIT_V(6); PG8_BAR; PG8_MMA(1, 1, At, B1); PG8_BAR;
    }
    E(acc, cur, wr, wc, fr, fq);
    if (!has_next) break;
#pragma unroll
    for (int a = 0; a < 2; ++a)
#pragma unroll
      for (int b = 0; b < 2; ++b)
#pragma unroll
        for (int m = 0; m < 4; ++m)
#pragma unroll
          for (int n = 0; n < 2; ++n) acc[a][b][m][n] = (f32x4){0.f, 0.f, 0.f, 0.f};
    cur = nxt; cA = nA; cB = nB; ++ui;
  }
  PG8_WAIT_V(0);
  if (wr == 0) PG8_BAR;
  PG8_BAR;
#undef PG8_SA
#undef PG8_SB
#undef PG8_STAGE
#undef PG8_LDA
#undef PG8_LDB
#undef PG8_MMA
#undef PG8_WAIT_V
#undef PG8_WAIT_L
#undef PG8_BAR
#undef PG8_SCHED
}
}

#define XB_TMO      128
#define XB_XCNT(j)  (256  + 64 * (j))
#define XB_XSUB(j)  (1280 + 64 * (j))
#define XB_XGEN(j)  (2304 + 64 * (j))
#define XB_TOP      3328
#define XB_TOPGEN   3392
#define XCD_BAR_WORDS 3456
#define XB_SPIN_CAP (1u << 18)
#define LAS __attribute__((address_space(3)))
DEV unsigned xb_ld(unsigned* p) { return __hip_atomic_load(p, __ATOMIC_RELAXED, __HIP_MEMORY_SCOPE_AGENT); }
DEV unsigned xb_add(unsigned* p, unsigned v) { return __hip_atomic_fetch_add(p, v, __ATOMIC_RELAXED, __HIP_MEMORY_SCOPE_AGENT); }
DEV unsigned xb_xcc_id() { return (unsigned)__builtin_amdgcn_s_getreg((3 << 11) | 20) & 0xFu; }
#define XB_SPIN(cond, bar) do { unsigned _sp = 0; while (cond) { __builtin_amdgcn_s_sleep(1); \
    if ((++_sp & 255u) == 0u) { if (xb_ld(&(bar)[XB_TMO])) break; if (_sp > XB_SPIN_CAP) { atomicAdd(&(bar)[XB_TMO], 1u); break; } } } } while (0)
struct XcdBarrier { unsigned* bar; unsigned x; volatile LAS unsigned* st; };
DEV XcdBarrier xcd_barrier_post(unsigned* bar, volatile LAS unsigned* st) {
  XcdBarrier b; b.bar = bar; b.x = xb_xcc_id(); b.st = st;
  if (threadIdx.x == 0) (void)xb_add(&bar[XB_XCNT(b.x)], 1u);
  return b;
}
DEV void xcd_barrier_complete(unsigned* bar, unsigned x, unsigned& nloc, unsigned& nx) {
  const unsigned G = gridDim.x * gridDim.y * gridDim.z;
  unsigned sum, cnt, mine, sp = 0u;
  for (;;) {
    sum = 0u; cnt = 0u; mine = 0u;
#pragma unroll
    for (unsigned j = 0; j < 16; ++j) { const unsigned c = xb_ld(&bar[XB_XCNT(j)]); sum += c; cnt += (c > 0u) ? 1u : 0u; mine = (j == x) ? c : mine; }
    if (sum == G) break;
    __builtin_amdgcn_s_sleep(1);
    if ((++sp & 255u) == 0u) { if (xb_ld(&bar[XB_TMO])) break; if (sp > XB_SPIN_CAP) { atomicAdd(&bar[XB_TMO], 1u); break; } }
  }
  nloc = mine > 0u ? mine : 1u; nx = cnt > 0u ? cnt : 1u;
}
DEV void xcd_barrier(const XcdBarrier& b0) {
  XcdBarrier b = b0;
  asm volatile("" : "+s"(b.bar));
  b.x = xb_xcc_id();
  asm volatile("s_waitcnt vmcnt(0)" ::: "memory");
  __syncthreads();
  if (threadIdx.x == 0) {
    unsigned* bar = b.bar;
    __builtin_amdgcn_s_waitcnt(0);
    unsigned nloc = b.st[0], nx = b.st[1];
    if (nloc == 0u) { xcd_barrier_complete(bar, b.x, nloc, nx); b.st[0] = nloc; b.st[1] = nx; }
    const unsigned old = xb_add(&bar[XB_XSUB(b.x)], 1u);
    const unsigned gen = old / nloc;
    if (old + 1u == (gen + 1u) * nloc) {
      __builtin_amdgcn_fence(__ATOMIC_RELEASE, "agent");
      asm volatile("s_waitcnt vmcnt(0)" ::: "memory");
      const unsigned og = xb_add(&bar[XB_TOP], 1u);
      const unsigned tg = og / nx;
      if (og + 1u == (tg + 1u) * nx) xb_add(&bar[XB_TOPGEN], 1u);
      else XB_SPIN(xb_ld(&bar[XB_TOPGEN]) == tg, bar);
      __builtin_amdgcn_fence(__ATOMIC_ACQUIRE, "agent");
      xb_add(&bar[XB_XGEN(b.x)], 1u);
      asm volatile("s_waitcnt vmcnt(0)" ::: "memory");
    } else {
      XB_SPIN(xb_ld(&bar[XB_XGEN(b.x)]) == gen, bar);
      __builtin_amdgcn_fence(__ATOMIC_ACQUIRE, "agent");
      asm volatile("s_waitcnt vmcnt(0)" ::: "memory");
    }
  }
  __syncthreads();
}

__global__ void __launch_bounds__(512, 2) mega_kernel(Params p0) {
  Params p = p0;
#define PH_REFRESH { char* w_ = p0.ws; asm volatile("" : "+s"(w_)); p.ws = w_; float* o_ = p0.out; asm volatile("" : "+s"(o_)); p.out = o_; }
  __shared__ __attribute__((aligned(16))) char smem_raw[SMEM_BYTES];
  const int vhalf = __builtin_amdgcn_readfirstlane(threadIdx.x >> 8);
  bf16_t* smem = (bf16_t*)(smem_raw + vhalf * SMEM_VB);
  float* smf = (float*)(smem_raw + vhalf * SMEM_VB);
  PG8_LAS unsigned char* lds8 = (PG8_LAS unsigned char*)smem_raw;
  u32x4& xb_words = *(u32x4*)(smem_raw + 2 * SMEM_VB);
  cg::grid_group grid = cg::this_grid();
  const int bid = VBID, nb = VNB;
  if (threadIdx.x == 0) { u32x4 z; z.x = 0; z.y = 0; z.z = 0; z.w = 0; xb_words = z; }
  __syncthreads();
  const XcdBarrier xb = xcd_barrier_post((unsigned*)(p.ws + WS_BAR), (volatile LAS unsigned*)&xb_words);
  if (p0.ws == nullptr) grid.sync();

  phase0(p, smf);
  xcd_barrier(xb);
 PH_REFRESH
  row_phase(p, 0, 0);
  xcd_barrier(xb);
 PH_REFRESH

  for (int l = 0; l < 4; ++l) {
    if ((l & 1) == 0) {
      const int e = l >> 1;
      { pg8::StaticOrder S; S.init(NTOK, 1536, (int)gridDim.x, (int)blockIdx.x);
        pg8::gemm_phase(lds8, pg8::Gemm{(const bf16_t*)(p.ws + WS_H), (const bf16_t*)(p.ws + WS_WINE) + (size_t)e * 2048 * 1024, NTOK, 1536, 1024}, S,
                        pg8::EpiInEven{(bf16_t*)(p.ws + WS_UG), (bf16_t*)(p.ws + WS_QD), (bf16_t*)(p.ws + WS_KD), p.out + O_DK, (const float*)(p.ws + WS_ROPED), e});
        pg8::StaticOrder S2; S2.init(512, NTOK, (int)gridDim.x, (int)((blockIdx.x + 128) & 255));
        pg8::gemm_phase(lds8, pg8::Gemm{(const bf16_t*)(p.ws + WS_WINE) + (size_t)e * 2048 * 1024 + (size_t)1536 * 1024, (const bf16_t*)(p.ws + WS_H), 512, NTOK, 1024}, S2,
                        pg8::EpiVt{(bf16_t*)(p.ws + WS_VTDC), (bf16_t*)(p.ws + WS_VTDL), p.out + O_DV, e}); }
      {
        const int c = (int)blockIdx.x;
        const int sel = (c >= 32 && c < 128) ? c - 32 : (c >= 224 ? 96 + (c - 224) : -1);
        if (sel >= 0) even_cache_tasks(p, e, smf, 2 * sel + (bid & 1), 256);
      }
      xcd_barrier(xb);
 PH_REFRESH
      for (int it = (int)blockIdx.x; it < 384 + 192; it += (int)gridDim.x) {
        const int task = it < 256 ? (((it & 7) * 4 + (it >> 6)) * 8 + ((it >> 3) & 7)) : it;
        if (it < 384) diff_attn_task(p, e, task, (bf16_t*)smem_raw);
        else s5_sgemm_tile(p, e, 2 * (it - 384) + (bid & 1), smem);
      }
      xcd_barrier(xb);
 PH_REFRESH
      s5_scan_phase(p, e);
      xcd_barrier(xb);
 PH_REFRESH
      {
        const int lv = ((int)blockIdx.x >> 3) * 2 + (bid & 1);
        if (lv < 48) s5_ygemm_tile(p, e, (((int)blockIdx.x & 7) * 4 + lv / 12) * 12 + lv % 12, smem);
      }
      xcd_barrier(xb);
 PH_REFRESH
      {
        const int lv = ((int)blockIdx.x >> 3) * 2 + (bid & 1);
        if (lv < 48) glu_tile(p, e, (((int)blockIdx.x & 7) * 12 + (lv >> 2)) * 4 + (lv & 3), smem);
      }
      xcd_barrier(xb);
 PH_REFRESH
      { pg8::StaticOrder S; S.init(NTOK, 1024, (int)gridDim.x, (int)blockIdx.x);
        pg8::gemm_phase(lds8, pg8::Gemm{(const bf16_t*)(p.ws + WS_YCAT), (const bf16_t*)(p.ws + WS_WOUTE) + (size_t)e * 1024 * 1024, NTOK, 1024, 1024}, S, pg8::EpiY{(bf16_t*)(p.ws + WS_Y)}); }
      xcd_barrier(xb);
 PH_REFRESH
    } else {
      const int o = l >> 1;
      {
        const int lv = ((int)blockIdx.x >> 3) * 2 + (bid & 1);
        if (lv < 48) odd_inproj_tile(p, o, (((int)blockIdx.x & 7) * 12 + (lv >> 2)) * 4 + (lv & 3), smem);
        else odd_cache_rows(p, o, ((int)blockIdx.x & 7) * 16 + (lv - 48), 128);
      }
      xcd_barrier(xb);
 PH_REFRESH
      odd_row_phase(p, o);
      xcd_barrier(xb);
 PH_REFRESH
      {
        const int x = (int)blockIdx.x & 7, lv = ((int)blockIdx.x >> 3) * 2 + (bid & 1);
        kvup_task(p, o, (x * 16 + (lv >> 2)) * 4 + (lv & 3), smem);
        for (int idx = lv; idx < 144; idx += 64) qup_tile(p, o, (x * 12 + idx / 12) * 12 + idx % 12, smem);
      }
      xcd_barrier(xb);
 PH_REFRESH
      for (int t = (int)blockIdx.x; t < 768; t += (int)gridDim.x) {
        const int bl = t & 255;
        const int task = t < 512 ? ((((t >> 8) * 64 + (bl & 7) * 8 + (bl >> 5)) * 4) + ((bl >> 3) & 3)) : t;
        mla_attn_task(p, task, (bf16_t*)smem_raw);
      }
      xcd_barrier(xb);
 PH_REFRESH
      { pg8::StaticOrder S; S.init(NTOK, 1024, (int)gridDim.x, (int)blockIdx.x);
        pg8::gemm_phase(lds8, pg8::Gemm{(const bf16_t*)(p.ws + WS_YCAT), (const bf16_t*)(p.ws + WS_WOUTO) + (size_t)o * 1024 * 1024, NTOK, 1024, 1024}, S, pg8::EpiY{(bf16_t*)(p.ws + WS_Y)}); }
      xcd_barrier(xb);
 PH_REFRESH
    }
    row_phase(p, 1, l);
    xcd_barrier(xb);
 PH_REFRESH
    { pg8::StaticOrder S; S.init(NTOK, 5632, (int)gridDim.x, (int)blockIdx.x);
      pg8::gemm_phase(lds8, pg8::Gemm{(const bf16_t*)(p.ws + WS_H), (const bf16_t*)(p.ws + WS_WGU) + (size_t)l * 5632 * 1024, NTOK, 5632, 1024}, S, pg8::EpiGateUp{(bf16_t*)(p.ws + WS_ACT)}); }
    if (l < 3 && blockIdx.x >= 32) tr_run(p, tr_layer_mask(l + 1), bid - 64, nb - 64, smf);
    xcd_barrier(xb);
 PH_REFRESH
    { pg8::StaticOrder S; S.init(NTOK, 1024, (int)gridDim.x, (int)blockIdx.x);
      pg8::gemm_phase(lds8, pg8::Gemm{(const bf16_t*)(p.ws + WS_ACT), (const bf16_t*)(p.ws + WS_WD) + (size_t)l * 1024 * 2816, NTOK, 1024, 2816}, S, pg8::EpiY{(bf16_t*)(p.ws + WS_Y)}); }
    if (l < 3 && blockIdx.x >= 192) {
      for (int t = bid - 384; t < 96; t += 128) mod_task(p, (l + 1) * 96 + t, smf);
    }
    xcd_barrier(xb);
 PH_REFRESH
    row_phase(p, 2, l);
    if (l < 3) xcd_barrier(xb);
 PH_REFRESH
  }
}

extern "C" void kernel_launch(void* const* d_in, const int* in_sizes, int n_in, void* d_out, int out_size,
                              void* d_ws, size_t ws_size, hipStream_t stream) {
  const int grid_blocks = 256;
  Params p{};
  for (int i = 0; i < 42; ++i) p.in[i] = (const float*)d_in[i];
  p.out = (float*)d_out;
  p.ws = (char*)d_ws;
  (void)hipMemsetAsync((char*)d_ws + WS_BAR, 0, XCD_BAR_WORDS * 4, stream);
  void* args[] = {&p};
  hipError_t err = hipLaunchCooperativeKernel((void*)mega_kernel, dim3(grid_blocks), dim3(512), args, 0, stream);
  if (err != hipSuccess) fprintf(stderr, "cooperative launch failed: %s (grid %d)\n", hipGetErrorString(err), grid_blocks);
}
```
